# Optimizing an MI355X kernel written in HIP

```python
import jax, jax.numpy as jnp
from jax import lax
import numpy as np

D_MODEL = 2048
BATCH = 8
SEQ = 2048
DEPTH = 1

HEAD_DIM = 64
N_Q_HEADS = 16
N_KV_HEADS = 4
GQA_GROUP = N_Q_HEADS // N_KV_HEADS
WINDOW = 128
ATTN_BLOCK = 128
ATTN_WIDTH = N_Q_HEADS * HEAD_DIM
KV_WIDTH = N_KV_HEADS * HEAD_DIM
SGU_GROUPS = 16
SGU_CHUNK = 128
SGU_WIDTH = 1024
SGU_GROUP_DIM = SGU_WIDTH // SGU_GROUPS
MIX_IN_WIDTH = ATTN_WIDTH + 2 * KV_WIDTH + 2 * SGU_WIDTH
N_BRANCHES = 2
D_FF = 5632
EPS = 1e-6
NEG_INF = -1e30

kernel_name = "hybrid_swa_sgu_macaron_block"


def alibi_slopes(n_heads):
    return np.asarray([2.0 ** (-8.0 * (i + 1) / n_heads) for i in range(n_heads)], dtype=np.float32)


def rmsnorm(x, g):
    xf = x.astype(jnp.float32)
    y = xf * lax.rsqrt(jnp.mean(xf * xf, axis=-1, keepdims=True) + EPS)
    return (y * g.astype(jnp.float32)).astype(x.dtype)


def layernorm(x, g, b):
    xf = x.astype(jnp.float32)
    mu = jnp.mean(xf, axis=-1, keepdims=True)
    xc = xf - mu
    y = xc * lax.rsqrt(jnp.mean(xc * xc, axis=-1, keepdims=True) + EPS)
    return (y * g.astype(jnp.float32) + b.astype(jnp.float32)).astype(x.dtype)


def swiglu(x, w_gate, w_up, w_down):
    return (jax.nn.silu(x @ w_gate) * (x @ w_up)) @ w_down


def sliding_window_attention(q, k, v, sinks):
    B, S = q.shape[0], q.shape[1]
    nb = S // ATTN_BLOCK
    qb = q.reshape(B, nb, ATTN_BLOCK, N_KV_HEADS, GQA_GROUP, HEAD_DIM)

    def band(t):
        prev = jnp.pad(t, ((0, 0), (ATTN_BLOCK, 0), (0, 0), (0, 0)))[:, :S]
        prev = prev.reshape(B, nb, ATTN_BLOCK, N_KV_HEADS, HEAD_DIM)
        cur = t.reshape(B, nb, ATTN_BLOCK, N_KV_HEADS, HEAD_DIM)
        return jnp.concatenate([prev, cur], axis=2)

    kb, vb = band(k), band(v)
    scores = jnp.einsum('bnqhgd,bnkhd->bnhgqk', qb, kb).astype(jnp.float32) * (HEAD_DIM ** -0.5)

    qpos = jnp.arange(ATTN_BLOCK)[:, None] + ATTN_BLOCK
    kpos = jnp.arange(2 * ATTN_BLOCK)[None, :]
    dist = (qpos - kpos).astype(jnp.float32)
    blk = jnp.arange(nb)[:, None, None]
    valid = (dist >= 0) & (dist < WINDOW) & (blk * ATTN_BLOCK + kpos[None] - ATTN_BLOCK >= 0)

    slopes = jnp.asarray(alibi_slopes(N_Q_HEADS)).reshape(N_KV_HEADS, GQA_GROUP)
    scores = scores - slopes[None, None, :, :, None, None] * jnp.abs(dist)[None, None, None, None]
    scores = jnp.where(valid[None, :, None, None], scores, NEG_INF)

    sink = sinks.astype(jnp.float32).reshape(N_KV_HEADS, GQA_GROUP)
    sink = jnp.broadcast_to(sink[None, None, :, :, None, None], scores.shape[:-1] + (1,))
    probs = jax.nn.softmax(jnp.concatenate([scores, sink], axis=-1), axis=-1)[..., :-1]
    out = jnp.einsum('bnhgqk,bnkhd->bnqhgd', probs.astype(v.dtype), vb)
    return out.reshape(B, S, ATTN_WIDTH)


def chunked_spatial_gating(u, z, ln_g, ln_b, w_s, b_s):
    B, S = u.shape[0], u.shape[1]
    nc = S // SGU_CHUNK
    z = layernorm(z, ln_g, ln_b).reshape(B, nc, SGU_CHUNK, SGU_GROUPS, SGU_GROUP_DIM)
    causal = jnp.tril(jnp.ones((SGU_CHUNK, SGU_CHUNK), dtype=bool))
    ws = jnp.where(causal[None], w_s, 0.0).astype(z.dtype)
    mixed = jnp.einsum('gts,bnsgc->bntgc', ws, z) + b_s.T[None, None, :, :, None].astype(z.dtype)
    return u * mixed.reshape(B, S, SGU_WIDTH)


def setup_inputs(seed: int = 0) -> dict:
    key = jax.random.key(seed)
    ks = jax.random.split(key, 24)
    L, D = DEPTH, D_MODEL

    def w(k, shape, fan_in, scale=1.0):
        return jax.random.normal(k, shape, dtype=jnp.float32) * (scale * fan_in ** -0.5)

    def gain(k, shape):
        return 1.0 + 0.05 * jax.random.normal(k, shape, dtype=jnp.float32)

    return {
        "x": jax.random.normal(ks[0], (BATCH, SEQ, D), dtype=jnp.float32),
        "ffn1_norm": gain(ks[1], (L, D)),
        "ffn1_w_gate": w(ks[2], (L, D, D_FF), D),
        "ffn1_w_up": w(ks[3], (L, D, D_FF), D),
        "ffn1_w_down": w(ks[4], (L, D_FF, D), D_FF),
        "mix_norm": gain(ks[5], (L, D)),
        "w_in": w(ks[6], (L, D, MIX_IN_WIDTH), D),
        "attn_sinks": 0.5 * jax.random.normal(ks[7], (L, N_Q_HEADS), dtype=jnp.float32),
        "sgu_norm_g": gain(ks[8], (L, SGU_WIDTH)),
        "sgu_norm_b": 0.02 * jax.random.normal(ks[9], (L, SGU_WIDTH), dtype=jnp.float32),
        "sgu_w_s": w(ks[10], (L, SGU_GROUPS, SGU_CHUNK, SGU_CHUNK), SGU_CHUNK, 0.5),
        "sgu_b_s": 1.0 + 0.1 * jax.random.normal(ks[11], (L, SGU_GROUPS, SGU_CHUNK), dtype=jnp.float32),
        "w_proj_attn": w(ks[12], (L, ATTN_WIDTH, D), ATTN_WIDTH),
        "w_proj_sgu": w(ks[13], (L, SGU_WIDTH, D), SGU_WIDTH),
        "w_branch_gate": w(ks[14], (L, D, N_BRANCHES * D), D),
        "b_branch_gate": 0.02 * jax.random.normal(ks[15], (L, N_BRANCHES * D), dtype=jnp.float32),
        "w_out": w(ks[16], (L, D, D), D),
        "ffn2_norm": gain(ks[17], (L, D)),
        "ffn2_w_gate": w(ks[18], (L, D, D_FF), D),
        "ffn2_w_up": w(ks[19], (L, D, D_FF), D),
        "ffn2_w_down": w(ks[20], (L, D_FF, D), D_FF),
        "final_norm": gain(ks[21], (D,)),
    }


def reference(x, ffn1_norm, ffn1_w_gate, ffn1_w_up, ffn1_w_down, mix_norm, w_in, attn_sinks,
              sgu_norm_g, sgu_norm_b, sgu_w_s, sgu_b_s, w_proj_attn, w_proj_sgu,
              w_branch_gate, b_branch_gate, w_out, ffn2_norm, ffn2_w_gate, ffn2_w_up,
              ffn2_w_down, final_norm):
    B, S = x.shape[0], x.shape[1]
    splits = np.cumsum([ATTN_WIDTH, KV_WIDTH, KV_WIDTH, SGU_WIDTH]).tolist()
    for l in range(DEPTH):
        x = x + 0.5 * swiglu(rmsnorm(x, ffn1_norm[l]), ffn1_w_gate[l], ffn1_w_up[l], ffn1_w_down[l])

        h = rmsnorm(x, mix_norm[l])
        proj = h @ w_in[l]
        q, k, v, u, z = jnp.split(proj, splits, axis=-1)
        attn = sliding_window_attention(
            q.reshape(B, S, N_Q_HEADS, HEAD_DIM),
            k.reshape(B, S, N_KV_HEADS, HEAD_DIM),
            v.reshape(B, S, N_KV_HEADS, HEAD_DIM),
            attn_sinks[l])
        sgu = chunked_spatial_gating(jax.nn.gelu(u), jax.nn.gelu(z), sgu_norm_g[l], sgu_norm_b[l],
                                     sgu_w_s[l], sgu_b_s[l])
        gates = jax.nn.sigmoid(h @ w_branch_gate[l] + b_branch_gate[l])
        g_attn, g_sgu = jnp.split(gates, N_BRANCHES, axis=-1)
        merged = g_attn * (attn @ w_proj_attn[l]) + g_sgu * (sgu @ w_proj_sgu[l])
        x = x + merged @ w_out[l]

        x = x + 0.5 * swiglu(rmsnorm(x, ffn2_norm[l]), ffn2_w_gate[l], ffn2_w_up[l], ffn2_w_down[l])
    return rmsnorm(x, final_norm)
```

```cpp
#include <hip/hip_runtime.h>
#include <hip/hip_cooperative_groups.h>
#include <cstdio>
#include <cstdint>
namespace pg8 {
#define PG8_LAS __attribute__((address_space(3)))
typedef unsigned short bf16_t;
typedef short bf16x8 __attribute__((ext_vector_type(8)));
typedef float f32x4 __attribute__((ext_vector_type(4)));
typedef unsigned u32x4 __attribute__((ext_vector_type(4)));
constexpr int BM = 256, BK = 64, HALF = 128, HTB = HALF * BK * 2  , STAGE_BYTES = 8 * HTB, NXCD = 8, WGM = 8;

__host__ __device__ __forceinline__ int lds_byte(int r, int c) { const int st = (r >> 4) * 2 + (c >> 5), rr = r & 15, cc = c & 31, ob = rr * 64 + cc * 2; return st * 1024 + (ob ^ (((ob >> 9) & 1) << 5)); }
__host__ __device__ __forceinline__ void stage_rc(int b, int& R, int& C) { const int st = b / 1024, sb = b % 1024, swz = sb ^ (((sb >> 9) & 1) << 5); R = (st >> 1) * 16 + swz / 64; C = (st & 1) * 32 + (swz % 64) / 2; }
__host__ __device__ __forceinline__ int perm32(int rho) { const int n = rho >> 4, i = rho & 15; return 8 * (i >> 2) + 4 * n + (i & 3); }

struct Unit { int pm, pn; };
struct Gemm { const bf16_t* A; const bf16_t* Bt; int M, N, K; };

struct StaticOrder {
    int nM, nN, nwg, G, c;
    __host__ __device__ void init(int M, int N, int G_, int c_) { nM = M / BM; nN = N / BM; nwg = nM * nN; G = G_; c = c_; }
    __host__ __device__ bool next(int i, Unit& u) const {
        const long L = (long)i * G + c; if (L >= nwg) return false;
        int wgid = (int)L; { const int q = nwg / NXCD, r = nwg % NXCD, xcd = wgid % NXCD, off = wgid / NXCD; wgid = (xcd < r ? xcd * (q + 1) : r * (q + 1) + (xcd - r) * q) + off; }
        const int nig = WGM * nN, gid = wgid / nig, fm = gid * WGM, gsz = (nM - fm) < WGM ? (nM - fm) : WGM;
        u.pm = fm + ((wgid % nig) % gsz); u.pn = (wgid % nig) / gsz; return true;
    }
    __device__ __forceinline__ void a_ready(const Unit&) const {}
    __device__ __forceinline__ void done(const Unit&) const {}
};

__device__ __forceinline__ unsigned cvt_pk_bf16(float lo, float hi) { unsigned r; asm volatile("v_cvt_pk_bf16_f32 %0, %1, %2" : "=v"(r) : "v"(lo), "v"(hi)); return r; }
template <class Epi, class Sched, bool ALIGN_EPI = false, bool SP2 = false>
__device__ __forceinline__ void gemm_phase(PG8_LAS unsigned char* lds, const Gemm g, const Sched& S, const Epi& E) {
    const int tid = threadIdx.x, wid = __builtin_amdgcn_readfirstlane(tid >> 6), lane = tid & 63, wr = wid >> 2, wc = wid & 3, fr = lane & 15, fq = lane >> 4;
    const int K = g.K, nt = K / BK;
    unsigned voffA[2], voffB[2];
#pragma unroll
    for (int i = 0; i < 2; ++i) { int R, C; stage_rc(tid * 16 + i * 8192, R, C); const int Rb = Epi::PERM ? ((R & ~31) + perm32(R & 31)) : R;
        voffA[i] = (unsigned)(R * K + C) * 2u; voffB[i] = (unsigned)(Rb * K + C) * 2u; }
    const size_t kstep = (size_t)(BK * 2);
    const size_t hstep = (size_t)HALF * K * 2;
    const size_t tstep = 2 * hstep;
    const unsigned ldsw = (unsigned)wid * 1024u;
    const int aoff = lds_byte(wr * 64 + fr, fq * 8), boff = lds_byte(wc * 32 + fr, fq * 8);
#define PG8_SA(b, h) (((b) * 2 + (h)) * HTB)
#define PG8_SB(b, h) ((4 + (b) * 2 + (h)) * HTB)
#define PG8_STAGE(bufoff, gbase, voff) do { _Pragma("unroll") for (int _i = 0; _i < 2; ++_i) \
        __builtin_amdgcn_global_load_lds((const unsigned*)((const char*)(gbase) + (voff)[_i]), (PG8_LAS unsigned*)(lds + (bufoff) + ldsw + _i * 8192), 16, 0, 0); } while (0)
#define PG8_LDA(dst, b, h) do { _Pragma("unroll") for (int m = 0; m < 4; ++m) _Pragma("unroll") for (int k = 0; k < 2; ++k) dst[m][k] = *(const PG8_LAS bf16x8*)(lds + PG8_SA(b, h) + aoff + m * 2048 + k * 1024); } while (0)
#define PG8_LDB(dst, b, h) do { _Pragma("unroll") for (int n = 0; n < 2; ++n) _Pragma("unroll") for (int k = 0; k < 2; ++k) dst[n][k] = *(const PG8_LAS bf16x8*)(lds + PG8_SB(b, h) + boff + n * 2048 + k * 1024); } while (0)
#define PG8_MMA(ai, bj, At, Bt) do { __builtin_amdgcn_s_setprio(1); _Pragma("unroll") for (int m = 0; m < 4; ++m) _Pragma("unroll") for (int n = 0; n < 2; ++n) _Pragma("unroll") for (int k = 0; k < 2; ++k) \
        acc[ai][bj][m][n] = __builtin_amdgcn_mfma_f32_16x16x32_bf16(Bt[n][k], At[m][k], acc[ai][bj][m][n], 0, 0, 0); __builtin_amdgcn_s_setprio(0); } while (0)
#define PG8_WAIT_V(n) asm volatile("s_waitcnt vmcnt(" #n ")" ::: "memory")
#define PG8_WAIT_L(n) asm volatile("s_waitcnt lgkmcnt(" #n ")" ::: "memory")
#define PG8_BAR __builtin_amdgcn_s_barrier()
#define PG8_SCHED __builtin_amdgcn_sched_barrier(0)
    Unit cur, nxt; int ui = 0;
    if (!S.next(0, cur)) return;
    f32x4 acc[2][2][4][2];
#pragma unroll
    for (int a = 0; a < 2; ++a)
#pragma unroll
        for (int b = 0; b < 2; ++b)
#pragma unroll
            for (int m = 0; m < 4; ++m)
#pragma unroll
                for (int n = 0; n < 2; ++n) acc[a][b][m][n] = (f32x4){0.f, 0.f, 0.f, 0.f};
    bf16x8 At[4][2], B0[2][2], B1[2][2];
    const char* cA = (const char*)g.A + (size_t)cur.pm * tstep; const char* cB = (const char*)g.Bt + (size_t)cur.pn * tstep;
    S.a_ready(cur);
    if constexpr (SP2) {
        PG8_STAGE(PG8_SB(0, 0), cB, voffB); PG8_STAGE(PG8_SB(0, 1), cB + hstep, voffB); PG8_STAGE(PG8_SA(0, 0), cA, voffA); PG8_STAGE(PG8_SA(0, 1), cA + hstep, voffA);
        if (wr == 1) PG8_BAR;
        PG8_WAIT_V(2); PG8_BAR;
        PG8_STAGE(PG8_SB(1, 0), cB + kstep, voffB); PG8_STAGE(PG8_SA(1, 0), cA + kstep, voffA); PG8_STAGE(PG8_SB(1, 1), cB + hstep + kstep, voffB);
        PG8_WAIT_V(6); PG8_BAR;
    } else {
        PG8_STAGE(PG8_SB(0, 0), cB, voffB); PG8_STAGE(PG8_SA(0, 0), cA, voffA); PG8_STAGE(PG8_SB(0, 1), cB + hstep, voffB); PG8_STAGE(PG8_SA(0, 1), cA + hstep, voffA);
        if (wr == 1) PG8_BAR;
        PG8_WAIT_V(4); PG8_BAR;
        PG8_STAGE(PG8_SB(1, 0), cB + kstep, voffB); PG8_STAGE(PG8_SA(1, 0), cA + kstep, voffA); PG8_STAGE(PG8_SB(1, 1), cB + hstep + kstep, voffB);
        PG8_WAIT_V(6); PG8_BAR;
    }
    for (;;) {
        const bool has_next = S.next(ui + 1, nxt);
        const char* nA = has_next ? (const char*)g.A + (size_t)nxt.pm * tstep : cA; const char* nB = has_next ? (const char*)g.Bt + (size_t)nxt.pn * tstep : cB;
        for (int t = 0; t < nt; t += 2) {
            const bool last = (t == nt - 2);
            const char* a1 = cA + (size_t)(t + 1) * kstep;
            const char* a2 = last ? nA : cA + (size_t)(t + 2) * kstep; const char* b2 = last ? nB : cB + (size_t)(t + 2) * kstep;
            const char* a3 = a2 + kstep; const char* b3 = b2 + kstep;
            if (last && has_next) S.a_ready(nxt);
            if constexpr (SP2) {
            PG8_LDB(B0, 0, 0); PG8_LDB(B1, 0, 1); PG8_SCHED; PG8_LDA(At, 0, 0); PG8_STAGE(PG8_SA(1, 1), a1 + hstep, voffA);
            PG8_WAIT_V(8); PG8_WAIT_L(0); PG8_BAR; PG8_MMA(0, 0, At, B0); PG8_MMA(0, 1, At, B1); PG8_BAR; PG8_SCHED;
            PG8_LDA(At, 0, 1); PG8_STAGE(PG8_SB(0, 0), b2, voffB); PG8_STAGE(PG8_SB(0, 1), b2 + hstep, voffB); PG8_STAGE(PG8_SA(0, 0), a2, voffA);
            PG8_WAIT_V(8); PG8_WAIT_L(0); PG8_BAR; PG8_MMA(1, 0, At, B0); PG8_MMA(1, 1, At, B1); PG8_BAR; PG8_SCHED;
            PG8_LDB(B0, 1, 0); PG8_LDB(B1, 1, 1); PG8_SCHED; PG8_LDA(At, 1, 0); PG8_STAGE(PG8_SA(0, 1), a2 + hstep, voffA);
            PG8_WAIT_V(8); PG8_WAIT_L(0); PG8_BAR; PG8_MMA(0, 0, At, B0); PG8_MMA(0, 1, At, B1); PG8_BAR; PG8_SCHED;
            PG8_LDA(At, 1, 1); PG8_STAGE(PG8_SB(1, 0), b3, voffB); PG8_STAGE(PG8_SB(1, 1), b3 + hstep, voffB); PG8_STAGE(PG8_SA(1, 0), a3, voffA);
            PG8_WAIT_V(8); PG8_WAIT_L(0); PG8_BAR; PG8_MMA(1, 0, At, B0); PG8_MMA(1, 1, At, B1); PG8_BAR; PG8_SCHED;
            } else {
            PG8_LDB(B0, 0, 0); PG8_SCHED; PG8_LDA(At, 0, 0); PG8_STAGE(PG8_SA(1, 1), a1 + hstep, voffA);
            PG8_WAIT_L(8); PG8_BAR; PG8_WAIT_L(0); PG8_MMA(0, 0, At, B0); PG8_BAR; PG8_SCHED;
            PG8_LDB(B1, 0, 1); PG8_STAGE(PG8_SB(0, 0), b2, voffB);
            PG8_BAR; PG8_WAIT_L(0); PG8_MMA(0, 1, At, B1); PG8_BAR;
            PG8_LDA(At, 0, 1); PG8_STAGE(PG8_SA(0, 0), a2, voffA);
            PG8_BAR; PG8_WAIT_L(0); PG8_MMA(1, 0, At, B0); PG8_BAR; PG8_SCHED;
            PG8_STAGE(PG8_SB(0, 1), b2 + hstep, voffB);
            PG8_WAIT_V(6); PG8_BAR; PG8_MMA(1, 1, At, B1); PG8_BAR;
            PG8_LDB(B0, 1, 0); PG8_SCHED; PG8_LDA(At, 1, 0); PG8_STAGE(PG8_SA(0, 1), a2 + hstep, voffA);
            PG8_WAIT_L(8); PG8_BAR; PG8_WAIT_L(0); PG8_MMA(0, 0, At, B0); PG8_BAR; PG8_SCHED;
            PG8_LDB(B1, 1, 1); PG8_STAGE(PG8_SB(1, 0), b3, voffB);
            PG8_BAR; PG8_WAIT_L(0); PG8_MMA(0, 1, At, B1); PG8_BAR;
            PG8_LDA(At, 1, 1); PG8_STAGE(PG8_SA(1, 0), a3, voffA);
            PG8_BAR; PG8_WAIT_L(0); PG8_MMA(1, 0, At, B0); PG8_BAR; PG8_SCHED;
            PG8_STAGE(PG8_SB(1, 1), b3 + hstep, voffB);
            PG8_WAIT_V(6); PG8_BAR; PG8_MMA(1, 1, At, B1); PG8_BAR;
            }
        }
        if constexpr (ALIGN_EPI) { if (wr == 0) PG8_BAR; }
        if constexpr (!Epi::AFTER_DRAIN) { E(acc, cur, wr, wc, fr, fq); S.done(cur); }
        if (!has_next) break;
#pragma unroll
        for (int a = 0; a < 2; ++a)
#pragma unroll
            for (int b = 0; b < 2; ++b)
#pragma unroll
                for (int m = 0; m < 4; ++m)
#pragma unroll
                    for (int n = 0; n < 2; ++n) acc[a][b][m][n] = (f32x4){0.f, 0.f, 0.f, 0.f};
        cur = nxt; cA = nA; cB = nB; ++ui;
        if constexpr (ALIGN_EPI) { if (wr == 1) PG8_BAR; }
    }
    PG8_WAIT_V(0);
    if constexpr (!ALIGN_EPI) { if (wr == 0) PG8_BAR; }
    PG8_BAR;
    if constexpr (Epi::AFTER_DRAIN) { E.fused(acc, cur, wr, wc, fr, fq, lds, wid, lane); S.done(cur); }
#undef PG8_SA
#undef PG8_SB
#undef PG8_STAGE
#undef PG8_LDA
#undef PG8_LDB
#undef PG8_MMA
#undef PG8_WAIT_V
#undef PG8_WAIT_L
#undef PG8_BAR
#undef PG8_SCHED
}
}

namespace pg8 {
typedef unsigned u32x2 __attribute__((ext_vector_type(2)));
__device__ __forceinline__ float sigm(float x) { return __builtin_amdgcn_rcpf(1.0f + __builtin_amdgcn_exp2f(-1.4426950409f * x)); }
__device__ __forceinline__ float silu_f(float x) { return x * sigm(x); }
__device__ __forceinline__ float gelu_tanh_f(float x) { return x * sigm(1.5957691216f * (x + 0.044715f * x * x * x)); }
__device__ __forceinline__ float bf2f(unsigned short b) { return __uint_as_float(((unsigned)b) << 16); }

template <bool SCALED> struct EpiSwiGLU {
    static constexpr bool PERM = true, AFTER_DRAIN = false;
    bf16_t* O; int ldc; const PG8_LAS float* rs;
    __device__ __forceinline__ void operator()(const f32x4 (&acc)[2][2][4][2], const Unit& u, int wr, int wc, int fr, int fq) const {
        const int row0 = u.pm * BM + wr * 64 + fr, col0 = u.pn * HALF + wc * 32 + 8 * fq;
#pragma unroll
        for (int ai = 0; ai < 2; ++ai)
#pragma unroll
            for (int m = 0; m < 4; ++m) {
                bf16_t* rowp = O + (size_t)(row0 + ai * HALF + m * 16) * ldc + col0;
                f32x4 g0 = acc[ai][0][m][0], g1 = acc[ai][0][m][1], u0 = acc[ai][1][m][0], u1 = acc[ai][1][m][1];
                if (SCALED) { const float r = rs[ai * HALF + wr * 64 + m * 16 + fr]; g0 = g0 * r; g1 = g1 * r; u0 = u0 * r; u1 = u1 * r; }
                u32x4 w;
                w.x = cvt_pk_bf16(silu_f(g0[0]) * u0[0], silu_f(g0[1]) * u0[1]); w.y = cvt_pk_bf16(silu_f(g0[2]) * u0[2], silu_f(g0[3]) * u0[3]);
                w.z = cvt_pk_bf16(silu_f(g1[0]) * u1[0], silu_f(g1[1]) * u1[1]); w.w = cvt_pk_bf16(silu_f(g1[2]) * u1[2], silu_f(g1[3]) * u1[3]);
                *(u32x4*)rowp = w;
            }
    }
};
template <bool NORM> struct EpiResid {
    static constexpr bool PERM = false, AFTER_DRAIN = false;
    const float* base; float* out; int ldc; float scale; bf16_t* xb; float* ssq;
    __device__ __forceinline__ void operator()(const f32x4 (&acc)[2][2][4][2], const Unit& u, int wr, int wc, int fr, int fq) const {
        int row0 = u.pm * BM + wr * 64 + fr, col0 = u.pn * BM + wc * 32 + 4 * fq;
        asm volatile("" : "+v"(row0), "+v"(col0));
        f32x4 b[2][2][2][2];
#pragma unroll
        for (int ch = 0; ch <= 4; ++ch) {
            if (ch < 4) {
#pragma unroll
                for (int mm = 0; mm < 2; ++mm) { const size_t off = (size_t)(row0 + (ch >> 1) * HALF + ((ch & 1) * 2 + mm) * 16) * ldc + col0;
#pragma unroll
                    for (int bj = 0; bj < 2; ++bj)
#pragma unroll
                        for (int n = 0; n < 2; ++n) b[ch & 1][mm][bj][n] = *(const f32x4*)(base + off + bj * HALF + n * 16); }
            }
            asm volatile("" ::: "memory");
            if (ch > 0) {
                const int pc = ch - 1, ai = pc >> 1;
#pragma unroll
                for (int mm = 0; mm < 2; ++mm) { const int m = (pc & 1) * 2 + mm, row = row0 + ai * HALF + m * 16; const size_t off = (size_t)row * ldc + col0;
                    float s = 0.f;
#pragma unroll
                    for (int bj = 0; bj < 2; ++bj)
#pragma unroll
                        for (int n = 0; n < 2; ++n) {
                            const f32x4 o = b[pc & 1][mm][bj][n] + acc[ai][bj][m][n] * scale;
                            *(f32x4*)(out + off + bj * HALF + n * 16) = o;
                            if (NORM) { s += (o[0] * o[0] + o[1] * o[1]) + (o[2] * o[2] + o[3] * o[3]);
                                u32x2 w; w.x = cvt_pk_bf16(o[0], o[1]); w.y = cvt_pk_bf16(o[2], o[3]); *(u32x2*)(xb + off + bj * HALF + n * 16) = w; }
                        }
                    if (NORM) { s += __shfl_xor(s, 16); s += __shfl_xor(s, 32); ssq[(size_t)row * 32 + u.pn * 4 + wc] = s; }
                }
            }
            asm volatile("" ::: "memory");
        }
    }
};
struct EpiMix {
    static constexpr bool PERM = true, AFTER_DRAIN = false;
    bf16_t *Q, *K, *V, *U, *Z, *G; const float* gbias; float* stats; const PG8_LAS float* rs;
    __device__ __forceinline__ void operator()(const f32x4 (&acc)[2][2][4][2], const Unit& u, int wr, int wc, int fr, int fq) const {
        const int pn = u.pn, row0 = u.pm * BM + wr * 64 + fr, cin = wc * 32 + 8 * fq;
        bf16_t* base; int ld, mode;
        if (pn < 4) { base = Q + pn * BM; ld = 1024; mode = 0; }
        else if (pn == 4) { base = K; ld = 256; mode = 0; }
        else if (pn == 5) { base = V; ld = 256; mode = 0; }
        else if (pn < 10) { base = U + (pn - 6) * BM; ld = 1024; mode = 1; }
        else if (pn < 14) { base = Z + (pn - 10) * BM; ld = 1024; mode = 2; }
        else { base = G + (pn - 14) * BM; ld = 4096; mode = 3; }
        f32x4 bv[2][2];
#pragma unroll
        for (int bj = 0; bj < 2; ++bj)
#pragma unroll
            for (int n = 0; n < 2; ++n) bv[bj][n] = (mode == 3) ? *(const f32x4*)(gbias + (pn - 14) * BM + cin + bj * HALF + 4 * n) : (f32x4){0.f, 0.f, 0.f, 0.f};
#pragma unroll
        for (int ai = 0; ai < 2; ++ai)
#pragma unroll
            for (int m = 0; m < 4; ++m) {
                const int row = row0 + ai * HALF + m * 16;
                bf16_t* rowp = base + (size_t)row * ld + cin;
                const float rsv = rs[ai * HALF + wr * 64 + m * 16 + fr];
                float s1 = 0.f, s2 = 0.f;
#pragma unroll
                for (int bj = 0; bj < 2; ++bj) {
                    f32x4 v0 = acc[ai][bj][m][0] * rsv + bv[bj][0], v1 = acc[ai][bj][m][1] * rsv + bv[bj][1];
                    if (mode == 1 || mode == 2) {
#pragma unroll
                        for (int e = 0; e < 4; ++e) { v0[e] = gelu_tanh_f(v0[e]); v1[e] = gelu_tanh_f(v1[e]); }
                    } else if (mode == 3) {
#pragma unroll
                        for (int e = 0; e < 4; ++e) { v0[e] = sigm(v0[e]); v1[e] = sigm(v1[e]); }
                    }
                    if (mode == 2) {
#pragma unroll
                        for (int e = 0; e < 4; ++e) { s1 += v0[e] + v1[e]; s2 += v0[e] * v0[e] + v1[e] * v1[e]; }
                    }
                    u32x4 w; w.x = cvt_pk_bf16(v0[0], v0[1]); w.y = cvt_pk_bf16(v0[2], v0[3]); w.z = cvt_pk_bf16(v1[0], v1[1]); w.w = cvt_pk_bf16(v1[2], v1[3]);
                    *(u32x4*)(rowp + bj * HALF) = w;
                }
                if (mode == 2) {
                    s1 += __shfl_xor(s1, 16); s1 += __shfl_xor(s1, 32); s2 += __shfl_xor(s2, 16); s2 += __shfl_xor(s2, 32);
                    if (fq == 0) { float* sp = stats + ((size_t)row * 16 + (pn - 10) * 4 + wc) * 2; sp[0] = s1; sp[1] = s2; }
                }
            }
    }
};
template <bool SECOND> struct EpiGate {
    static constexpr bool PERM = true, AFTER_DRAIN = false;
    const bf16_t* G; bf16_t* T;
    __device__ __forceinline__ void operator()(const f32x4 (&acc)[2][2][4][2], const Unit& u, int wr, int wc, int fr, int fq) const {
        int row0 = u.pm * BM + wr * 64 + fr, col0 = u.pn * BM + wc * 32 + 8 * fq;
        asm volatile("" : "+v"(row0), "+v"(col0));
        u32x4 gw[2][2][2], tw[2][2][2];
#pragma unroll
        for (int ch = 0; ch <= 4; ++ch) {
            if (ch < 4) {
#pragma unroll
                for (int mm = 0; mm < 2; ++mm) { const size_t row = (size_t)(row0 + (ch >> 1) * HALF + ((ch & 1) * 2 + mm) * 16);
#pragma unroll
                    for (int bj = 0; bj < 2; ++bj) { const int c = col0 + bj * HALF;
                        gw[ch & 1][mm][bj] = *(const u32x4*)(G + row * 4096 + (SECOND ? 2048 : 0) + c);
                        if (SECOND) tw[ch & 1][mm][bj] = *(const u32x4*)(T + row * 2048 + c); } }
            }
            asm volatile("" ::: "memory");
            if (ch > 0) {
                const int pc = ch - 1, ai = pc >> 1;
#pragma unroll
                for (int mm = 0; mm < 2; ++mm) { const int m = (pc & 1) * 2 + mm; const size_t row = (size_t)(row0 + ai * HALF + m * 16);
#pragma unroll
                    for (int bj = 0; bj < 2; ++bj) { const int c = col0 + bj * HALF;
                        const f32x4 a0 = acc[ai][bj][m][0], a1 = acc[ai][bj][m][1];
                        float o[8];
#pragma unroll
                        for (int e = 0; e < 4; ++e) {
                            const unsigned gwe = gw[pc & 1][mm][bj][e], twe = SECOND ? tw[pc & 1][mm][bj][e] : 0u;
                            const float glo = __uint_as_float(gwe << 16), ghi = __uint_as_float(gwe & 0xffff0000u);
                            const float tlo = __uint_as_float(twe << 16), thi = __uint_as_float(twe & 0xffff0000u);
                            const float alo = (e < 2) ? a0[2 * e] : a1[2 * e - 4], ahi = (e < 2) ? a0[2 * e + 1] : a1[2 * e - 3];
                            o[2 * e] = tlo + glo * alo; o[2 * e + 1] = thi + ghi * ahi;
                        }
                        u32x4 w; w.x = cvt_pk_bf16(o[0], o[1]); w.y = cvt_pk_bf16(o[2], o[3]); w.z = cvt_pk_bf16(o[4], o[5]); w.w = cvt_pk_bf16(o[6], o[7]);
                        *(u32x4*)(T + row * 2048 + c) = w;
                    } }
            }
            asm volatile("" ::: "memory");
        }
    }
};
}

namespace cg = cooperative_groups;
#define LAS __attribute__((address_space(3)))
typedef unsigned short bf16;
typedef float f32x4 __attribute__((ext_vector_type(4)));
typedef unsigned v4u __attribute__((ext_vector_type(4)));
typedef unsigned v2u __attribute__((ext_vector_type(2)));
typedef short bf16x8 __attribute__((ext_vector_type(8)));
typedef short s16x4 __attribute__((ext_vector_type(4)));

constexpr int NWAVES = 8;
constexpr int BATCH = 8, SEQ = 2048, D = 2048, FF = 5632, M = BATCH * SEQ;
constexpr int AW = 1024, KVW = 256, SW = 1024, NMIX = 3584 + 4096;
constexpr float EPS = 1e-6f;
constexpr size_t MiB = 1u << 20;
constexpr size_t WS_STATS = 0, WS_WSM = 2 * MiB, WS_WGU1 = 3 * MiB, WS_WD1 = 47 * MiB, WS_WGU2 = 69 * MiB, WS_WD2 = 113 * MiB, WS_WMIX = 135 * MiB,
                 WS_PA = 165 * MiB, WS_PB = 169 * MiB, WS_WOUT = 173 * MiB, WS_H = 181 * MiB, WS_ACT = 245 * MiB,
                 WS_Q = 245 * MiB, WS_K = 277 * MiB, WS_V = 285 * MiB, WS_U = 293 * MiB, WS_Z = 325 * MiB, WS_G = 357 * MiB, WS_SSQ = 485 * MiB, WS_END = 487 * MiB,
                 WS_T = WS_WGU1;
static_assert(WS_WGU1 + (size_t)2 * FF * D * 2 == WS_WD1 && WS_WD1 + (size_t)D * FF * 2 == WS_WGU2 && WS_WMIX + (size_t)NMIX * D * 2 == WS_PA && WS_H + (size_t)M * D * 2 == WS_ACT &&
              WS_ACT + (size_t)M * FF * 2 <= WS_END && WS_G + (size_t)M * 4096 * 2 == WS_SSQ && WS_T + (size_t)M * D * 2 <= WS_WGU2, "d_ws map");
constexpr size_t WS_BAR = 2 * MiB + 768 * 1024, BAR_BYTES = 16384;
constexpr int MISC_OFF = 131072 + 1024, RS_OFF = 131072 + 2048;
constexpr int LDS_BYTES = 147456;

enum { I_X = 0, I_N1, I_WG1, I_WU1, I_WD1, I_NMIX, I_WIN, I_SINK, I_LNG, I_LNB, I_WS, I_BS, I_PA, I_PB, I_WGATE, I_BGATE, I_WOUT, I_N2, I_WG2, I_WU2, I_WD2, I_NF, N_IN };

struct Args { const float* in[N_IN]; float* out; unsigned char* ws; int ph_lo, ph_hi; };

__device__ __forceinline__ unsigned f2bf(float f) { unsigned u = __builtin_bit_cast(unsigned, f); return (u + 0x7fffu + ((u >> 16) & 1u)) >> 16; }
__device__ __forceinline__ unsigned pk2(float lo, float hi) { unsigned r; asm("v_cvt_pk_bf16_f32 %0, %1, %2" : "=v"(r) : "v"(lo), "v"(hi)); return r; }
__device__ __forceinline__ float wave_sum(float v) {
#pragma unroll
    for (int o = 1; o < 64; o <<= 1) v += __shfl_xor(v, o);
    return v;
}
#define LDS_WAIT() asm volatile("s_waitcnt lgkmcnt(0)" ::: "memory")

#define XB_TMO      128
#define XB_XCNT(j)  (256  + 64 * (j))
#define XB_XSUB(j)  (1280 + 64 * (j))
#define XB_XGEN(j)  (2304 + 64 * (j))
#define XB_TOP      3328
#define XB_TOPGEN   3392
#define XCD_BAR_WORDS 3456
#define XB_SPIN_CAP (1u << 18)

__device__ __forceinline__ unsigned xb_ld(unsigned* p)              { return __hip_atomic_load(p, __ATOMIC_RELAXED, __HIP_MEMORY_SCOPE_AGENT); }
__device__ __forceinline__ unsigned xb_add(unsigned* p, unsigned v) { return __hip_atomic_fetch_add(p, v, __ATOMIC_RELAXED, __HIP_MEMORY_SCOPE_AGENT); }
__device__ __forceinline__ unsigned xb_xcc_id() { return (unsigned)__builtin_amdgcn_s_getreg((3 << 11) | 20) & 0xFu; }
#define XB_SPIN(cond, bar) do { unsigned _sp = 0; while (cond) { __builtin_amdgcn_s_sleep(1); \
    if ((++_sp & 255u) == 0u) { if (xb_ld(&(bar)[XB_TMO])) break; if (_sp > XB_SPIN_CAP) { atomicAdd(&(bar)[XB_TMO], 1u); break; } } } } while (0)

struct XcdBarrier {
    unsigned* bar; unsigned x;
    volatile LAS unsigned* st;
};

__device__ __forceinline__ XcdBarrier xcd_barrier_post(unsigned* bar, volatile LAS unsigned* st) {
    XcdBarrier b; b.bar = bar; b.x = xb_xcc_id(); b.st = st;
    if (threadIdx.x == 0) (void)xb_add(&bar[XB_XCNT(b.x)], 1u);
    return b;
}
__device__ __forceinline__ void xcd_barrier_complete(unsigned* bar, unsigned x, unsigned& nloc, unsigned& nx) {
    const unsigned G = gridDim.x * gridDim.y * gridDim.z;
    unsigned sum, cnt, mine, sp = 0u;
    for (;;) {
        sum = 0u; cnt = 0u; mine = 0u;
#pragma unroll
        for (unsigned j = 0; j < 16; ++j) { const unsigned c = xb_ld(&bar[XB_XCNT(j)]); sum += c; cnt += (c > 0u) ? 1u : 0u; mine = (j == x) ? c : mine; }
        if (sum == G) break;
        __builtin_amdgcn_s_sleep(1);
        if ((++sp & 255u) == 0u) { if (xb_ld(&bar[XB_TMO])) break; if (sp > XB_SPIN_CAP) { atomicAdd(&bar[XB_TMO], 1u); break; } }
    }
    nloc = mine > 0u ? mine : 1u; nx = cnt > 0u ? cnt : 1u;
}

__device__ __forceinline__ void xcd_barrier(const XcdBarrier& b) {
    asm volatile("s_waitcnt vmcnt(0)" ::: "memory");
    __syncthreads();
    if (threadIdx.x == 0) {
        unsigned* bar = b.bar;
        __builtin_amdgcn_s_waitcnt(0);
        unsigned nloc = b.st[0], nx = b.st[1];
        if (nloc == 0u) { xcd_barrier_complete(bar, b.x, nloc, nx); b.st[0] = nloc; b.st[1] = nx; }
        const unsigned old = xb_add(&bar[XB_XSUB(b.x)], 1u);
        const unsigned gen = old / nloc;
        if (old + 1u == (gen + 1u) * nloc) {
            __builtin_amdgcn_fence(__ATOMIC_RELEASE, "agent");
            asm volatile("s_waitcnt vmcnt(0)" ::: "memory");
            const unsigned og = xb_add(&bar[XB_TOP], 1u);
            const unsigned tg = og / nx;
            if (og + 1u == (tg + 1u) * nx) xb_add(&bar[XB_TOPGEN], 1u);
            else XB_SPIN(xb_ld(&bar[XB_TOPGEN]) == tg, bar);
            __builtin_amdgcn_fence(__ATOMIC_ACQUIRE, "agent");
            xb_add(&bar[XB_XGEN(b.x)], 1u);
            asm volatile("s_waitcnt vmcnt(0)" ::: "memory");
        } else {
            XB_SPIN(xb_ld(&bar[XB_XGEN(b.x)]) == gen, bar);
            __builtin_amdgcn_fence(__ATOMIC_ACQUIRE, "agent");
            asm volatile("s_waitcnt vmcnt(0)" ::: "memory");
        }
    }
    __syncthreads();
}

__device__ __forceinline__ void transpose_item(const float* W, int K, int N, bf16* WT, int mode, int row_off, const float* gain, int item, int lane) {
    const int nblk = N / 64, kb = item / nblk, nb = item % nblk, k0 = 64 * kb, n0 = 64 * nb;
    const int rbase = (mode == 0) ? (row_off + n0) : ((n0 >> 7) * 256 + (n0 & 127) + row_off);
    const float* src = W + (size_t)k0 * N + n0 + lane;
    float v[64];
#pragma unroll
    for (int i = 0; i < 64; ++i) v[i] = src[(size_t)i * N];
    if (gain) {
#pragma unroll
        for (int i = 0; i < 64; ++i) v[i] *= gain[k0 + i];
    }
    bf16* dst = WT + (size_t)(rbase + lane) * K + k0;
#pragma unroll
    for (int c = 0; c < 8; ++c) { v4u o; o.x = pk2(v[8 * c], v[8 * c + 1]); o.y = pk2(v[8 * c + 2], v[8 * c + 3]); o.z = pk2(v[8 * c + 4], v[8 * c + 5]); o.w = pk2(v[8 * c + 6], v[8 * c + 7]);
        *(v4u*)(dst + 8 * c) = o; }
}
template <bool OUT_BF16> __device__ __forceinline__ void rms_rows(const float* X, const float* gain, void* out, int gw, int ngw, int lane) {
    int m = gw;
    for (; m + ngw < M; m += 2 * ngw) {
        const f32x4* xr0 = (const f32x4*)(X + (size_t)m * D) + lane; const f32x4* xr1 = (const f32x4*)(X + (size_t)(m + ngw) * D) + lane;
        f32x4 v0[8], v1[8]; float s0 = 0.f, s1 = 0.f;
#pragma unroll
        for (int j = 0; j < 8; ++j) { v0[j] = xr0[64 * j]; v1[j] = xr1[64 * j]; }
#pragma unroll
        for (int j = 0; j < 8; ++j) { s0 += (v0[j].x * v0[j].x + v0[j].y * v0[j].y) + (v0[j].z * v0[j].z + v0[j].w * v0[j].w); s1 += (v1[j].x * v1[j].x + v1[j].y * v1[j].y) + (v1[j].z * v1[j].z + v1[j].w * v1[j].w); }
        const float rs0 = 1.0f / sqrtf(wave_sum(s0) * (1.0f / D) + EPS), rs1 = 1.0f / sqrtf(wave_sum(s1) * (1.0f / D) + EPS);
#pragma unroll
        for (int j = 0; j < 8; ++j) {
            const f32x4 g = ((const f32x4*)gain)[lane + 64 * j]; const f32x4 o0 = v0[j] * rs0 * g, o1 = v1[j] * rs1 * g;
            if (OUT_BF16) { v2u w0, w1; w0.x = pk2(o0.x, o0.y); w0.y = pk2(o0.z, o0.w); w1.x = pk2(o1.x, o1.y); w1.y = pk2(o1.z, o1.w);
                ((v2u*)((bf16*)out + (size_t)m * D))[lane + 64 * j] = w0; ((v2u*)((bf16*)out + (size_t)(m + ngw) * D))[lane + 64 * j] = w1; }
            else { ((f32x4*)((float*)out + (size_t)m * D))[lane + 64 * j] = o0; ((f32x4*)((float*)out + (size_t)(m + ngw) * D))[lane + 64 * j] = o1; }
        }
    }
    for (; m < M; m += ngw) {
        const f32x4* xr = (const f32x4*)(X + (size_t)m * D) + lane;
        f32x4 v[8]; float s = 0.f;
#pragma unroll
        for (int j = 0; j < 8; ++j) { v[j] = xr[64 * j]; s += (v[j].x * v[j].x + v[j].y * v[j].y) + (v[j].z * v[j].z + v[j].w * v[j].w); }
        const float rs = 1.0f / sqrtf(wave_sum(s) * (1.0f / D) + EPS);
#pragma unroll
        for (int j = 0; j < 8; ++j) {
            const f32x4 g = ((const f32x4*)gain)[lane + 64 * j]; const f32x4 o = v[j] * rs * g;
            if (OUT_BF16) { v2u w; w.x = pk2(o.x, o.y); w.y = pk2(o.z, o.w); ((v2u*)((bf16*)out + (size_t)m * D))[lane + 64 * j] = w; }
            else ((f32x4*)((float*)out + (size_t)m * D))[lane + 64 * j] = o;
        }
    }
}

constexpr int KS_LD = 72, VT_LD = 264, KS_BYTES = 256 * KS_LD * 2;
template <bool FULL> __device__ __forceinline__ void attn_qtile(const LAS bf16* Ks, const LAS bf16* Vt, const bf16* QO, bf16* Oout, int row_cur, int h, int qt, int fr, int fq, float slope8, float sink8) {
    const int qi = qt * 16 + fr, kt0 = qt < 6 ? qt : 6;
    const bf16* qrow = QO + (size_t)(row_cur + qi) * AW + h * 64; bf16* orow = Oout + (size_t)(row_cur + qi) * AW + h * 64;
    bf16x8 qf[2]; qf[0] = *(const bf16x8*)(qrow + fq * 8); qf[1] = *(const bf16x8*)(qrow + 32 + fq * 8);
    const int d0 = 128 + qi - kt0 * 16 - fq * 4;
    const int e0 = 128 - kt0 * 16 - fq * 4;
    const float a0 = -slope8 * (float)d0;
    f32x4 S[10];
#pragma unroll
    for (int j = 0; j < 10; ++j) {
#pragma unroll
        for (int i = 0; i < 4; ++i) S[j][i] = fmaf(slope8, (float)(16 * j + i), a0);
#pragma unroll
        for (int ks = 0; ks < 2; ++ks) {
            const bf16x8 kf = *(const LAS bf16x8*)(Ks + ((kt0 + j) * 16 + fr) * KS_LD + ks * 32 + fq * 8);
            S[j] = __builtin_amdgcn_mfma_f32_16x16x32_bf16(kf, qf[ks], S[j], 0, 0, 0);
        }
    }
    float mx = sink8;
#pragma unroll
    for (int j = 0; j < 10; ++j)
#pragma unroll
        for (int i = 0; i < 4; ++i) {
            if (FULL || j < 2 || j > 7) {
                const int c = 16 * j + i; bool ok = (unsigned)(d0 - c) < 128u; if (FULL) ok = ok && (c >= e0);
                S[j][i] = ok ? S[j][i] : -1e30f;
            }
            mx = fmaxf(mx, S[j][i]);
        }
    mx = fmaxf(mx, __shfl_xor(mx, 16)); mx = fmaxf(mx, __shfl_xor(mx, 32));
    const float C = 0.125f * 1.4426950409f, nm = -mx * C;
    float sum = 0.f;
#pragma unroll
    for (int j = 0; j < 10; ++j)
#pragma unroll
        for (int i = 0; i < 4; ++i) { const float p = __builtin_amdgcn_exp2f(fmaf(S[j][i], C, nm)); S[j][i] = p; sum += p; }
    sum += __shfl_xor(sum, 16); sum += __shfl_xor(sum, 32);
    sum += __builtin_amdgcn_exp2f(fmaf(sink8, C, nm));
    const float inv = 1.0f / sum;
    f32x4 O[4];
#pragma unroll
    for (int dt = 0; dt < 4; ++dt) O[dt] = (f32x4){0.f, 0.f, 0.f, 0.f};
#pragma unroll
    for (int kk = 0; kk < 5; ++kk) {
        v4u pw; pw.x = pk2(S[2 * kk][0], S[2 * kk][1]); pw.y = pk2(S[2 * kk][2], S[2 * kk][3]); pw.z = pk2(S[2 * kk + 1][0], S[2 * kk + 1][1]); pw.w = pk2(S[2 * kk + 1][2], S[2 * kk + 1][3]);
        const bf16x8 pb = __builtin_bit_cast(bf16x8, pw);
#pragma unroll
        for (int dt = 0; dt < 4; ++dt) {
            const LAS bf16* vp = Vt + (dt * 16 + fr) * VT_LD + (kt0 + 2 * kk) * 16 + fq * 4;
            const v2u a0v = *(const LAS v2u*)vp, a1v = *(const LAS v2u*)(vp + 16);
            v4u aw; aw.x = a0v.x; aw.y = a0v.y; aw.z = a1v.x; aw.w = a1v.y;
            O[dt] = __builtin_amdgcn_mfma_f32_16x16x32_bf16(__builtin_bit_cast(bf16x8, aw), pb, O[dt], 0, 0, 0);
        }
    }
#pragma unroll
    for (int dt = 0; dt < 4; ++dt) { v2u w; w.x = pk2(O[dt][0] * inv, O[dt][1] * inv); w.y = pk2(O[dt][2] * inv, O[dt][3] * inv); *(v2u*)(orow + dt * 16 + fq * 4) = w; }
}

__device__ __forceinline__ void attn_unit(LAS unsigned char* lds, const bf16* QO, bf16* Oout, const bf16* Kb, const bf16* Vb, const float* sinks, int unit, int tid, int wave, int lane) {
    const int b = unit >> 6, blk = (unit >> 2) & 15, kvh = unit & 3;
    const int row_cur = b * SEQ + blk * 128;
    LAS bf16* Ks = (LAS bf16*)lds; LAS bf16* Vt = (LAS bf16*)(lds + KS_BYTES);
    __syncthreads();
#pragma unroll
    for (int i = 0; i < 4; ++i) {
        const int idx = tid + i * 512, key = idx >> 3, ch = idx & 7; const bool ok = (blk > 0) || (key >= 128);
        v4u v = (v4u){0u, 0u, 0u, 0u}; if (ok) v = *(const v4u*)(Kb + (size_t)(row_cur - 128 + key) * KVW + kvh * 64 + ch * 8);
        *(LAS v4u*)(Ks + key * KS_LD + ch * 8) = v;
    }
#pragma unroll
    for (int i = 0; i < 4; ++i) {
        const int idx = tid + i * 512, key = idx & 255, ch = idx >> 8; const bool ok = (blk > 0) || (key >= 128);
        v4u v = (v4u){0u, 0u, 0u, 0u}; if (ok) v = *(const v4u*)(Vb + (size_t)(row_cur - 128 + key) * KVW + kvh * 64 + ch * 8);
#pragma unroll
        for (int e = 0; e < 4; ++e) { Vt[(ch * 8 + 2 * e) * VT_LD + key] = (bf16)(v[e] & 0xffffu); Vt[(ch * 8 + 2 * e + 1) * VT_LD + key] = (bf16)(v[e] >> 16); }
    }
    __syncthreads();
    const int h = kvh * 4 + (wave >> 1), fr = lane & 15, fq = lane >> 4;
    const float slope8 = 8.0f * __builtin_amdgcn_exp2f(-0.5f * (float)(h + 1)), sink8 = 8.0f * sinks[h];
    if (blk == 0) { for (int qq = 0; qq < 4; ++qq) attn_qtile<true>(Ks, Vt, QO, Oout, row_cur, h, (wave & 1) * 4 + qq, fr, fq, slope8, sink8); }
    else          { for (int qq = 0; qq < 4; ++qq) attn_qtile<false>(Ks, Vt, QO, Oout, row_cur, h, (wave & 1) * 4 + qq, fr, fq, slope8, sink8); }
}

constexpr int ZT_LD = 136, ZT_BYTES = 256 * ZT_LD * 2;
__device__ __forceinline__ void sgu_unit(LAS unsigned char* lds, const bf16* U, bf16* Uout, const bf16* Zb, const float* stats, const float* lng, const float* lnb, const bf16* wsm, const float* bs,
                                         int unit, int tid, int wave, int lane) {
    const int b = unit >> 6, chunk = (unit >> 2) & 15, gq = unit & 3;
    const int row0 = b * SEQ + chunk * 128, colbase = gq * 256;
    LAS bf16* zt = (LAS bf16*)lds; LAS float* st = (LAS float*)(lds + ZT_BYTES);
    __syncthreads();
    if (tid < 128) {
        const f32x4* sp = (const f32x4*)(stats + (size_t)(row0 + tid) * 32); float s1 = 0.f, s2 = 0.f;
#pragma unroll
        for (int p = 0; p < 8; ++p) { const f32x4 v = sp[p]; s1 += v.x + v.z; s2 += v.y + v.w; }
        const float mu = s1 * (1.0f / SW), var = fmaxf(s2 * (1.0f / SW) - mu * mu, 0.f);
        st[2 * tid] = mu; st[2 * tid + 1] = 1.0f / sqrtf(var + EPS);
    }
    __syncthreads();
#pragma unroll 2
    for (int i = 0; i < 8; ++i) {
        const int idx = tid + i * 512, s = idx & 127, c8 = idx >> 7;
        const v4u z = *(const v4u*)(Zb + (size_t)(row0 + s) * SW + colbase + c8 * 8);
        const float mu = st[2 * s], rstd = st[2 * s + 1];
        const float* gp = lng + colbase + c8 * 8; const float* bp = lnb + colbase + c8 * 8;
#pragma unroll
        for (int e = 0; e < 4; ++e) {
            const float zlo = __uint_as_float(z[e] << 16), zhi = __uint_as_float(z[e] & 0xffff0000u);
            const unsigned zp = pk2((zlo - mu) * rstd * gp[2 * e] + bp[2 * e], (zhi - mu) * rstd * gp[2 * e + 1] + bp[2 * e + 1]);
            zt[(c8 * 8 + 2 * e) * ZT_LD + s] = (bf16)(zp & 0xffffu);
            zt[(c8 * 8 + 2 * e + 1) * ZT_LD + s] = (bf16)(zp >> 16);
        }
    }
    __syncthreads();
    const int fr = lane & 15, fq = lane >> 4, t = wave * 16 + fr, nks = (wave >> 1) + 1;
    f32x4 acc[16];
#pragma unroll
    for (int ct = 0; ct < 16; ++ct) acc[ct] = (f32x4){0.f, 0.f, 0.f, 0.f};
    for (int ks = 0; ks < nks; ++ks) {
        bf16x8 wb[4];
#pragma unroll
        for (int gi = 0; gi < 4; ++gi) wb[gi] = *(const bf16x8*)(wsm + ((size_t)((gq * 4 + gi) * 128 + t)) * 128 + ks * 32 + fq * 8);
#pragma unroll
        for (int ct = 0; ct < 16; ++ct) {
            const bf16x8 za = *(const LAS bf16x8*)(zt + (ct * 16 + fr) * ZT_LD + ks * 32 + fq * 8);
            acc[ct] = __builtin_amdgcn_mfma_f32_16x16x32_bf16(za, wb[ct >> 2], acc[ct], 0, 0, 0);
        }
    }
    const bf16* urow = U + (size_t)(row0 + t) * SW + colbase + fq * 4; bf16* uorow = Uout + (size_t)(row0 + t) * SW + colbase + fq * 4;
#pragma unroll
    for (int ct = 0; ct < 16; ++ct) {
        const float bias = bs[(gq * 4 + (ct >> 2)) * 128 + t];
        const v2u uw = *(const v2u*)(urow + ct * 16);
        const float u0 = __uint_as_float(uw.x << 16), u1 = __uint_as_float(uw.x & 0xffff0000u), u2 = __uint_as_float(uw.y << 16), u3 = __uint_as_float(uw.y & 0xffff0000u);
        v2u w; w.x = pk2(u0 * (acc[ct][0] + bias), u1 * (acc[ct][1] + bias)); w.y = pk2(u2 * (acc[ct][2] + bias), u3 * (acc[ct][3] + bias));
        *(v2u*)(uorow + ct * 16) = w;
    }
}

__device__ __forceinline__ void panel_scales(LAS unsigned char* lds, const float* ssq, int pm, int tid) {
    const int r = tid >> 1, h = tid & 1;
    const f32x4* p = (const f32x4*)(ssq + (size_t)(pm * 256 + r) * 32 + h * 16);
    const f32x4 a = p[0], b = p[1], c = p[2], d = p[3];
    float sum = (((a.x + a.y) + (a.z + a.w)) + ((b.x + b.y) + (b.z + b.w))) + (((c.x + c.y) + (c.z + c.w)) + ((d.x + d.y) + (d.z + d.w)));
    sum += __shfl_xor(sum, 1);
    if (h == 0) ((LAS float*)(lds + RS_OFF))[r] = 1.0f / sqrtf(sum * (1.0f / D) + EPS);
    __syncthreads();
}

#ifndef MK_N_LAUNCHES
#define MK_N_LAUNCHES 1
#endif
constexpr int N_PHASES = 12;
constexpr int IT_FF = (D / 64) * (FF / 64), IT_DN = (FF / 64) * (D / 64), IT_WIN = (D / 64) * (3584 / 64), IT_WG = (D / 64) * (4096 / 64), IT_P = (AW / 64) * (D / 64), IT_O = (D / 64) * (D / 64);
constexpr int N_EARLY = 2 * IT_FF + IT_DN + IT_WIN + IT_WG, N_LATE = 2 * IT_P + IT_O + 2 * IT_FF + IT_DN;
static_assert(N_LATE % 8 == 0, "late items are dealt over 8 queue heads");

__global__ void __launch_bounds__(NWAVES * 64, 2) hybrid_fwd(Args args) {
    extern __shared__ __attribute__((aligned(16))) unsigned char lds_raw[];
    LAS unsigned char* lds = (LAS unsigned char*)lds_raw;
    const int tid = threadIdx.x, lane = tid & 63, wave = __builtin_amdgcn_readfirstlane(tid >> 6);
    const int G = gridDim.x, gw = blockIdx.x * NWAVES + wave, ngw = G * NWAVES;
    unsigned char* ws = args.ws;
    const int lo = args.ph_lo, hi = args.ph_hi;
#define IN(k) (lo <= (k) && (k) < hi)
    if (tid < 64) ((LAS unsigned*)(lds + MISC_OFF))[tid] = 0u;
    __syncthreads();
    XcdBarrier bar; bar.bar = (unsigned*)(ws + WS_BAR); bar.x = 0; bar.st = (volatile LAS unsigned*)(lds + MISC_OFF + 32);
    if (hi - lo > 1) bar = xcd_barrier_post((unsigned*)(ws + WS_BAR), (volatile LAS unsigned*)(lds + MISC_OFF + 32));
#define SEAM(k) do { if (IN(k) && IN((k) + 1)) xcd_barrier(bar); } while (0)
    if (lo < 0) cg::this_grid().sync();
    bf16* Hb = (bf16*)(ws + WS_H); bf16* ACT = (bf16*)(ws + WS_ACT); bf16* Tb = (bf16*)(ws + WS_T); float* ssq = (float*)(ws + WS_SSQ);
    bf16 *Qb = (bf16*)(ws + WS_Q), *Kb = (bf16*)(ws + WS_K), *Vb = (bf16*)(ws + WS_V), *Ub = (bf16*)(ws + WS_U), *Zb = (bf16*)(ws + WS_Z), *Gb = (bf16*)(ws + WS_G);
    float* stats = (float*)(ws + WS_STATS); bf16* wsm = (bf16*)(ws + WS_WSM);

    if (IN(0)) {
        for (int it = gw; it < N_EARLY; it += ngw) {
            int r = it;
            if (r < IT_FF) { transpose_item(args.in[I_WG1], D, FF, (bf16*)(ws + WS_WGU1), 1, 0, nullptr, r, lane); continue; } r -= IT_FF;
            if (r < IT_FF) { transpose_item(args.in[I_WU1], D, FF, (bf16*)(ws + WS_WGU1), 1, 128, nullptr, r, lane); continue; } r -= IT_FF;
            if (r < IT_DN) { transpose_item(args.in[I_WD1], FF, D, (bf16*)(ws + WS_WD1), 0, 0, nullptr, r, lane); continue; } r -= IT_DN;
            if (r < IT_WIN) { transpose_item(args.in[I_WIN], D, 3584, (bf16*)(ws + WS_WMIX), 0, 0, args.in[I_NMIX], r, lane); continue; } r -= IT_WIN;
            transpose_item(args.in[I_WGATE], D, 4096, (bf16*)(ws + WS_WMIX), 0, 3584, args.in[I_NMIX], r, lane);
        }
        for (int e = blockIdx.x * 512 + tid; e < 16 * 128 * 128; e += G * 512) { const int s = e & 127, t = (e >> 7) & 127; wsm[e] = (s <= t) ? (bf16)f2bf(args.in[I_WS][e]) : (bf16)0; }
        rms_rows<true>(args.in[I_X], args.in[I_N1], Hb, gw, ngw, lane);
    }
    SEAM(0);
    if (IN(1)) {
        pg8::Gemm g{Hb, (const bf16*)(ws + WS_WGU1), M, 2 * FF, D}; pg8::StaticOrder S; S.init(M, 2 * FF, G, (int)blockIdx.x);
        pg8::EpiSwiGLU<false> E{ACT, FF, nullptr};
        pg8::gemm_phase<pg8::EpiSwiGLU<false>, pg8::StaticOrder, true, true>(lds, g, S, E);
    }
    SEAM(1);
    if (IN(2)) {
        pg8::Gemm g{ACT, (const bf16*)(ws + WS_WD1), M, D, FF}; pg8::StaticOrder S; S.init(M, D, G, (int)blockIdx.x);
        pg8::EpiResid<true> E{args.in[I_X], args.out, D, 0.5f, Hb, ssq};
        pg8::gemm_phase<pg8::EpiResid<true>, pg8::StaticOrder, true, true>(lds, g, S, E);
    }
    SEAM(2);
    if (IN(4)) {
        pg8::Gemm g{Hb, (const bf16*)(ws + WS_WMIX), M, NMIX, D}; pg8::StaticOrder S; S.init(M, NMIX, G, (int)blockIdx.x);
        { pg8::Unit u0; if (S.next(0, u0)) panel_scales(lds, ssq, u0.pm, tid); else __syncthreads(); }
        pg8::EpiMix E{Qb, Kb, Vb, Ub, Zb, Gb, args.in[I_BGATE], stats, (const LAS float*)(lds + RS_OFF)};
        pg8::gemm_phase<pg8::EpiMix, pg8::StaticOrder, true, true>(lds, g, S, E);
        unsigned* qheads = (unsigned*)(ws + WS_BAR + 14336);
        const int myq = (int)(xb_xcc_id() & 7u);
        for (int q = 0; q < 8; ++q) {
            const int qi = (myq + q) & 7;
            for (;;) {
                int t = 0;
                if (lane == 0) t = (int)__hip_atomic_fetch_add(qheads + 64 * qi, 1u, __ATOMIC_RELAXED, __HIP_MEMORY_SCOPE_AGENT);
                t = __builtin_amdgcn_readfirstlane(t);
                if (t >= N_LATE / 8) break;
                int r = t * 8 + qi;
                if (r < IT_P) { transpose_item(args.in[I_PA], AW, D, (bf16*)(ws + WS_PA), 0, 0, nullptr, r, lane); continue; } r -= IT_P;
                if (r < IT_P) { transpose_item(args.in[I_PB], SW, D, (bf16*)(ws + WS_PB), 0, 0, nullptr, r, lane); continue; } r -= IT_P;
                if (r < IT_O) { transpose_item(args.in[I_WOUT], D, D, (bf16*)(ws + WS_WOUT), 0, 0, nullptr, r, lane); continue; } r -= IT_O;
                if (r < IT_FF) { transpose_item(args.in[I_WG2], D, FF, (bf16*)(ws + WS_WGU2), 1, 0, args.in[I_N2], r, lane); continue; } r -= IT_FF;
                if (r < IT_FF) { transpose_item(args.in[I_WU2], D, FF, (bf16*)(ws + WS_WGU2), 1, 128, args.in[I_N2], r, lane); continue; } r -= IT_FF;
                transpose_item(args.in[I_WD2], FF, D, (bf16*)(ws + WS_WD2), 0, 0, nullptr, r, lane);
            }
        }
    }
    SEAM(4);
    if (IN(5)) {
        for (int i = blockIdx.x; i < 1024; i += G) {
            if (i < 512) attn_unit(lds, Qb, Qb, Kb, Vb, args.in[I_SINK], i, tid, wave, lane);
            else sgu_unit(lds, Ub, Ub, Zb, stats, args.in[I_LNG], args.in[I_LNB], wsm, args.in[I_BS], i - 512, tid, wave, lane);
        }
        __syncthreads();
    }
    SEAM(5);
    if (IN(6)) {
        { pg8::Gemm g{Qb, (const bf16*)(ws + WS_PA), M, D, AW}; pg8::StaticOrder S; S.init(M, D, G, (int)blockIdx.x);
          pg8::EpiGate<false> E{Gb, Tb}; pg8::gemm_phase<pg8::EpiGate<false>, pg8::StaticOrder, true, true>(lds, g, S, E); }
        { pg8::Gemm g{Ub, (const bf16*)(ws + WS_PB), M, D, SW}; pg8::StaticOrder S; S.init(M, D, G, (int)blockIdx.x);
          pg8::EpiGate<true> E{Gb, Tb}; pg8::gemm_phase<pg8::EpiGate<true>, pg8::StaticOrder, true, true>(lds, g, S, E); }
    }
    SEAM(6);
    if (IN(7)) {
        pg8::Gemm g{Tb, (const bf16*)(ws + WS_WOUT), M, D, D}; pg8::StaticOrder S; S.init(M, D, G, (int)blockIdx.x);
        pg8::EpiResid<true> E{args.out, args.out, D, 1.0f, Hb, ssq};
        pg8::gemm_phase<pg8::EpiResid<true>, pg8::StaticOrder, true, true>(lds, g, S, E);
    }
    SEAM(7);
    if (IN(9)) {
        pg8::Gemm g{Hb, (const bf16*)(ws + WS_WGU2), M, 2 * FF, D}; pg8::StaticOrder S; S.init(M, 2 * FF, G, (int)blockIdx.x);
        { pg8::Unit u0; if (S.next(0, u0)) panel_scales(lds, ssq, u0.pm, tid); else __syncthreads(); }
        pg8::EpiSwiGLU<true> E{ACT, FF, (const LAS float*)(lds + RS_OFF)};
        pg8::gemm_phase<pg8::EpiSwiGLU<true>, pg8::StaticOrder, true, true>(lds, g, S, E);
    }
    SEAM(9);
    if (IN(10)) {
        pg8::Gemm g{ACT, (const bf16*)(ws + WS_WD2), M, D, FF}; pg8::StaticOrder S; S.init(M, D, G, (int)blockIdx.x);
        pg8::EpiResid<false> E{args.out, args.out, D, 0.5f, nullptr, nullptr};
        pg8::gemm_phase<pg8::EpiResid<false>, pg8::StaticOrder, true, true>(lds, g, S, E);
    }
    SEAM(10);
    if (IN(11)) rms_rows<false>(args.out, args.in[I_NF], args.out, gw, ngw, lane);
#undef IN
#undef SEAM
}

extern "C" void kernel_launch(void* const* d_in, const int* in_sizes, int n_in, void* d_out, int out_size, void* d_ws, size_t ws_size, hipStream_t stream) {
    static int grid = 0;
    if (grid == 0) {
        if (n_in != N_IN || in_sizes[0] != M * D || out_size != M * D || ws_size < WS_END) { fprintf(stderr, "kernel_launch: unexpected shapes (n_in %d, in0 %d, out %d, ws %zu)\n", n_in, n_in > 0 ? in_sizes[0] : -1, out_size, ws_size); grid = -1; return; }
        int dev = 0, cus = 0, per_cu = 0;
        if (hipGetDevice(&dev) != hipSuccess || hipDeviceGetAttribute(&cus, hipDeviceAttributeMultiprocessorCount, dev) != hipSuccess) { grid = -1; return; }
        if (hipFuncSetAttribute((const void*)hybrid_fwd, hipFuncAttributeMaxDynamicSharedMemorySize, LDS_BYTES) != hipSuccess) { fprintf(stderr, "kernel_launch: hipFuncSetAttribute failed\n"); grid = -1; return; }
        if (hipOccupancyMaxActiveBlocksPerMultiprocessor(&per_cu, (const void*)hybrid_fwd, NWAVES * 64, LDS_BYTES) != hipSuccess || per_cu < 1) { fprintf(stderr, "kernel_launch: occupancy query says %d\n", per_cu); per_cu = 1; }
        (void)hipGetLastError();
        grid = (cus / 64) * 64;
        if (grid < 64) { fprintf(stderr, "kernel_launch: needs at least 64 CUs\n"); grid = -1; return; }
        (void)per_cu;
    }
    if (grid < 0) return;
    if (hipMemsetAsync((char*)d_ws + WS_BAR, 0, BAR_BYTES, stream) != hipSuccess) { fprintf(stderr, "kernel_launch: memset failed\n"); return; }
    Args a{};
    for (int i = 0; i < N_IN; ++i) a.in[i] = (const float*)d_in[i];
    a.out = (float*)d_out; a.ws = (unsigned char*)d_ws;
#if MK_N_LAUNCHES == 1
    a.ph_lo = 0; a.ph_hi = N_PHASES;
    void* kargs[] = {&a};
    hipError_t e = hipLaunchCooperativeKernel((const void*)hybrid_fwd, dim3(grid), dim3(NWAVES * 64), kargs, LDS_BYTES, stream);
    if (e != hipSuccess) fprintf(stderr, "kernel_launch: cooperative launch failed: %s (grid %d)\n", hipGetErrorString(e), grid);
#else
    for (int p = 0; p < N_PHASES; ++p) {
        a.ph_lo = p; a.ph_hi = p + 1;
        hipLaunchKernelGGL(hybrid_fwd, dim3(grid), dim3(NWAVES * 64), LDS_BYTES, stream, a);
    }
#endif
}
```

```cpp
#include <hip/hip_runtime.h>
#include <hip/hip_cooperative_groups.h>
#include <cstdio>
#include <cstdint>
namespace pg8 {
#define PG8_LAS __attribute__((address_space(3)))
typedef unsigned short bf16_t;
typedef short bf16x8 __attribute__((ext_vector_type(8)));
typedef float f32x4 __attribute__((ext_vector_type(4)));
typedef unsigned u32x4 __attribute__((ext_vector_type(4)));
constexpr int BM = 256, BK = 64, HALF = 128, HTB = HALF * BK * 2  , STAGE_BYTES = 8 * HTB, NXCD = 8, WGM = 8;

__host__ __device__ __forceinline__ int lds_byte(int r, int c) { const int st = (r >> 4) * 2 + (c >> 5), rr = r & 15, cc = c & 31, ob = rr * 64 + cc * 2; return st * 1024 + (ob ^ (((ob >> 9) & 1) << 5)); }
__host__ __device__ __forceinline__ void stage_rc(int b, int& R, int& C) { const int st = b / 1024, sb = b % 1024, swz = sb ^ (((sb >> 9) & 1) << 5); R = (st >> 1) * 16 + swz / 64; C = (st & 1) * 32 + (swz % 64) / 2; }
__host__ __device__ __forceinline__ int perm32(int rho) { const int n = rho >> 4, i = rho & 15; return 8 * (i >> 2) + 4 * n + (i & 3); }

struct Unit { int pm, pn; };
struct Gemm { const bf16_t* A; const bf16_t* Bt; int M, N, K; };

struct StaticOrder {
    int nM, nN, nwg, G, c;
    __host__ __device__ void init(int M, int N, int G_, int c_) { nM = M / BM; nN = N / BM; nwg = nM * nN; G = G_; c = c_; }
    __host__ __device__ bool next(int i, Unit& u) const {
        const long L = (long)i * G + c; if (L >= nwg) return false;
        int wgid = (int)L; { const int q = nwg / NXCD, r = nwg % NXCD, xcd = wgid % NXCD, off = wgid / NXCD; wgid = (xcd < r ? xcd * (q + 1) : r * (q + 1) + (xcd - r) * q) + off; }
        const int nig = WGM * nN, gid = wgid / nig, fm = gid * WGM, gsz = (nM - fm) < WGM ? (nM - fm) : WGM;
        u.pm = fm + ((wgid % nig) % gsz); u.pn = (wgid % nig) / gsz; return true;
    }
    __device__ __forceinline__ void a_ready(const Unit&) const {}
    __device__ __forceinline__ void done(const Unit&) const {}
};

__device__ __forceinline__ unsigned cvt_pk_bf16(float lo, float hi) { unsigned r; asm volatile("v_cvt_pk_bf16_f32 %0, %1, %2" : "=v"(r) : "v"(lo), "v"(hi)); return r; }
template <class Epi, class Sched, bool ALIGN_EPI = false, bool SP2 = false>
__device__ __forceinline__ void gemm_phase(PG8_LAS unsigned char* lds, const Gemm g, const Sched& S, const Epi& E) {
    const int tid = threadIdx.x, wid = __builtin_amdgcn_readfirstlane(tid >> 6), lane = tid & 63, wr = wid >> 2, wc = wid & 3, fr = lane & 15, fq = lane >> 4;
    const int K = g.K, nt = K / BK;
    unsigned voffA[2], voffB[2];
#pragma unroll
    for (int i = 0; i < 2; ++i) { int R, C; stage_rc(tid * 16 + i * 8192, R, C); const int Rb = Epi::PERM ? ((R & ~31) + perm32(R & 31)) : R;
        voffA[i] = (unsigned)(R * K + C) * 2u; voffB[i] = (unsigned)(Rb * K + C) * 2u; }
    const size_t kstep = (size_t)(BK * 2);
    const size_t hstep = (size_t)HALF * K * 2;
    const size_t tstep = 2 * hstep;
    const unsigned ldsw = (unsigned)wid * 1024u;
    const int aoff = lds_byte(wr * 64 + fr, fq * 8), boff = lds_byte(wc * 32 + fr, fq * 8);
    const __amdgpu_buffer_rsrc_t rsrc_voffA = __builtin_amdgcn_make_buffer_rsrc((void*)g.A, 0, 0x7ffffff0, 0x00020000), rsrc_voffB = __builtin_amdgcn_make_buffer_rsrc((void*)g.Bt, 0, 0x7ffffff0, 0x00020000);
    const char* const base_voffA = (const char*)g.A; const char* const base_voffB = (const char*)g.Bt;
#define PG8_SA(b, h) (((b) * 2 + (h)) * HTB)
#define PG8_SB(b, h) ((4 + (b) * 2 + (h)) * HTB)
#define PG8_STAGE(bufoff, gbase, voff) do { const int _so = (int)((const char*)(gbase) - base_##voff); _Pragma("unroll") for (int _i = 0; _i < 2; ++_i) \
        __builtin_amdgcn_raw_ptr_buffer_load_lds(rsrc_##voff, (PG8_LAS unsigned*)(lds + (bufoff) + ldsw + _i * 8192), 16, (int)(voff)[_i], _so, 0, 0); } while (0)
#define PG8_LDA(dst, b, h) do { _Pragma("unroll") for (int m = 0; m < 4; ++m) _Pragma("unroll") for (int k = 0; k < 2; ++k) dst[m][k] = *(const PG8_LAS bf16x8*)(lds + PG8_SA(b, h) + aoff + m * 2048 + k * 1024); } while (0)
#define PG8_LDB(dst, b, h) do { _Pragma("unroll") for (int n = 0; n < 2; ++n) _Pragma("unroll") for (int k = 0; k < 2; ++k) dst[n][k] = *(const PG8_LAS bf16x8*)(lds + PG8_SB(b, h) + boff + n * 2048 + k * 1024); } while (0)
#define PG8_MMA(ai, bj, At, Bt) do { __builtin_amdgcn_s_setprio(1); _Pragma("unroll") for (int m = 0; m < 4; ++m) _Pragma("unroll") for (int n = 0; n < 2; ++n) _Pragma("unroll") for (int k = 0; k < 2; ++k) \
        acc[ai][bj][m][n] = __builtin_amdgcn_mfma_f32_16x16x32_bf16(Bt[n][k], At[m][k], acc[ai][bj][m][n], 0, 0, 0); __builtin_amdgcn_s_setprio(0); } while (0)
#define PG8_WAIT_V(n) asm volatile("s_waitcnt vmcnt(" #n ")" ::: "memory")
#define PG8_WAIT_L(n) asm volatile("s_waitcnt lgkmcnt(" #n ")" ::: "memory")
#define PG8_BAR __builtin_amdgcn_s_barrier()
#define PG8_SCHED __builtin_amdgcn_sched_barrier(0)
    Unit cur, nxt; int ui = 0;
    if (!S.next(0, cur)) return;
    f32x4 acc[2][2][4][2];
#pragma unroll
    for (int a = 0; a < 2; ++a)
#pragma unroll
        for (int b = 0; b < 2; ++b)
#pragma unroll
            for (int m = 0; m < 4; ++m)
#pragma unroll
                for (int n = 0; n < 2; ++n) acc[a][b][m][n] = (f32x4){0.f, 0.f, 0.f, 0.f};
    bf16x8 At[4][2], B0[2][2], B1[2][2];
    const char* cA = (const char*)g.A + (size_t)cur.pm * tstep; const char* cB = (const char*)g.Bt + (size_t)cur.pn * tstep;
    S.a_ready(cur);
    if constexpr (SP2) {
        PG8_STAGE(PG8_SB(0, 0), cB, voffB); PG8_STAGE(PG8_SB(0, 1), cB + hstep, voffB); PG8_STAGE(PG8_SA(0, 0), cA, voffA); PG8_STAGE(PG8_SA(0, 1), cA + hstep, voffA);
        if (wr == 1) PG8_BAR;
        PG8_WAIT_V(2); PG8_BAR;
        PG8_STAGE(PG8_SB(1, 0), cB + kstep, voffB); PG8_STAGE(PG8_SA(1, 0), cA + kstep, voffA); PG8_STAGE(PG8_SB(1, 1), cB + hstep + kstep, voffB);
        PG8_WAIT_V(6); PG8_BAR;
    } else {
        PG8_STAGE(PG8_SB(0, 0), cB, voffB); PG8_STAGE(PG8_SA(0, 0), cA, voffA); PG8_STAGE(PG8_SB(0, 1), cB + hstep, voffB); PG8_STAGE(PG8_SA(0, 1), cA + hstep, voffA);
        if (wr == 1) PG8_BAR;
        PG8_WAIT_V(4); PG8_BAR;
        PG8_STAGE(PG8_SB(1, 0), cB + kstep, voffB); PG8_STAGE(PG8_SA(1, 0), cA + kstep, voffA); PG8_STAGE(PG8_SB(1, 1), cB + hstep + kstep, voffB);
        PG8_WAIT_V(6); PG8_BAR;
    }
    for (;;) {
        const bool has_next = S.next(ui + 1, nxt);
        const char* nA = has_next ? (const char*)g.A + (size_t)nxt.pm * tstep : cA; const char* nB = has_next ? (const char*)g.Bt + (size_t)nxt.pn * tstep : cB;
        for (int t = 0; t < nt; t += 2) {
            const bool last = (t == nt - 2);
            const char* a1 = cA + (size_t)(t + 1) * kstep;
            const char* a2 = last ? nA : cA + (size_t)(t + 2) * kstep; const char* b2 = last ? nB : cB + (size_t)(t + 2) * kstep;
            const char* a3 = a2 + kstep; const char* b3 = b2 + kstep;
            if (last && has_next) S.a_ready(nxt);
            if constexpr (SP2) {
            PG8_LDB(B0, 0, 0); PG8_LDB(B1, 0, 1); PG8_SCHED; PG8_LDA(At, 0, 0); PG8_STAGE(PG8_SA(1, 1), a1 + hstep, voffA);
            PG8_WAIT_V(8); PG8_WAIT_L(0); PG8_BAR; PG8_MMA(0, 0, At, B0); PG8_MMA(0, 1, At, B1); PG8_BAR; PG8_SCHED;
            PG8_LDA(At, 0, 1); PG8_STAGE(PG8_SB(0, 0), b2, voffB); PG8_STAGE(PG8_SB(0, 1), b2 + hstep, voffB); PG8_STAGE(PG8_SA(0, 0), a2, voffA);
            PG8_WAIT_V(8); PG8_WAIT_L(0); PG8_BAR; PG8_MMA(1, 0, At, B0); PG8_MMA(1, 1, At, B1); PG8_BAR; PG8_SCHED;
            PG8_LDB(B0, 1, 0); PG8_LDB(B1, 1, 1); PG8_SCHED; PG8_LDA(At, 1, 0); PG8_STAGE(PG8_SA(0, 1), a2 + hstep, voffA);
            PG8_WAIT_V(8); PG8_WAIT_L(0); PG8_BAR; PG8_MMA(0, 0, At, B0); PG8_MMA(0, 1, At, B1); PG8_BAR; PG8_SCHED;
            PG8_LDA(At, 1, 1); PG8_STAGE(PG8_SB(1, 0), b3, voffB); PG8_STAGE(PG8_SB(1, 1), b3 + hstep, voffB); PG8_STAGE(PG8_SA(1, 0), a3, voffA);
            PG8_WAIT_V(8); PG8_WAIT_L(0); PG8_BAR; PG8_MMA(1, 0, At, B0); PG8_MMA(1, 1, At, B1); PG8_BAR; PG8_SCHED;
            } else {
            PG8_LDB(B0, 0, 0); PG8_SCHED; PG8_LDA(At, 0, 0); PG8_STAGE(PG8_SA(1, 1), a1 + hstep, voffA);
            PG8_WAIT_L(8); PG8_BAR; PG8_WAIT_L(0); PG8_MMA(0, 0, At, B0); PG8_BAR; PG8_SCHED;
            PG8_LDB(B1, 0, 1); PG8_STAGE(PG8_SB(0, 0), b2, voffB);
            PG8_BAR; PG8_WAIT_L(0); PG8_MMA(0, 1, At, B1); PG8_BAR;
            PG8_LDA(At, 0, 1); PG8_STAGE(PG8_SA(0, 0), a2, voffA);
            PG8_BAR; PG8_WAIT_L(0); PG8_MMA(1, 0, At, B0); PG8_BAR; PG8_SCHED;
            PG8_STAGE(PG8_SB(0, 1), b2 + hstep, voffB);
            PG8_WAIT_V(6); PG8_BAR; PG8_MMA(1, 1, At, B1); PG8_BAR;
            PG8_LDB(B0, 1, 0); PG8_SCHED; PG8_LDA(At, 1, 0); PG8_STAGE(PG8_SA(0, 1), a2 + hstep, voffA);
            PG8_WAIT_L(8); PG8_BAR; PG8_WAIT_L(0); PG8_MMA(0, 0, At, B0); PG8_BAR; PG8_SCHED;
            PG8_LDB(B1, 1, 1); PG8_STAGE(PG8_SB(1, 0), b3, voffB);
            PG8_BAR; PG8_WAIT_L(0); PG8_MMA(0, 1, At, B1); PG8_BAR;
            PG8_LDA(At, 1, 1); PG8_STAGE(PG8_SA(1, 0), a3, voffA);
            PG8_BAR; PG8_WAIT_L(0); PG8_MMA(1, 0, At, B0); PG8_BAR; PG8_SCHED;
            PG8_STAGE(PG8_SB(1, 1), b3 + hstep, voffB);
            PG8_WAIT_V(6); PG8_BAR; PG8_MMA(1, 1, At, B1); PG8_BAR;
            }
        }
        if constexpr (ALIGN_EPI) { if (wr == 0) PG8_BAR; }
        if constexpr (!Epi::AFTER_DRAIN) { E(acc, cur, wr, wc, fr, fq); S.done(cur); }
        if (!has_next) break;
#pragma unroll
        for (int a = 0; a < 2; ++a)
#pragma unroll
            for (int b = 0; b < 2; ++b)
#pragma unroll
                for (int m = 0; m < 4; ++m)
#pragma unroll
                    for (int n = 0; n < 2; ++n) acc[a][b][m][n] = (f32x4){0.f, 0.f, 0.f, 0.f};
        cur = nxt; cA = nA; cB = nB; ++ui;
        if constexpr (ALIGN_EPI) { if (wr == 1) PG8_BAR; }
    }
    PG8_WAIT_V(0);
    if constexpr (!ALIGN_EPI) { if (wr == 0) PG8_BAR; }
    PG8_BAR;
    if constexpr (Epi::AFTER_DRAIN) { E.fused(acc, cur, wr, wc, fr, fq, lds, wid, lane); S.done(cur); }
#undef PG8_SA
#undef PG8_SB
#undef PG8_STAGE
#undef PG8_LDA
#undef PG8_LDB
#undef PG8_MMA
#undef PG8_WAIT_V
#undef PG8_WAIT_L
#undef PG8_BAR
#undef PG8_SCHED
}
}

namespace pg8 {
typedef unsigned u32x2 __attribute__((ext_vector_type(2)));
__device__ __forceinline__ float sigm(float x) { return __builtin_amdgcn_rcpf(1.0f + __builtin_amdgcn_exp2f(-1.4426950409f * x)); }
__device__ __forceinline__ float silu_f(float x) { return x * sigm(x); }
__device__ __forceinline__ float gelu_tanh_f(float x) { return x * sigm(1.5957691216f * (x + 0.044715f * x * x * x)); }
__device__ __forceinline__ float bf2f(unsigned short b) { return __uint_as_float(((unsigned)b) << 16); }

template <bool SCALED> struct EpiSwiGLU {
    static constexpr bool PERM = true, AFTER_DRAIN = false;
    bf16_t* O; int ldc; const PG8_LAS float* rs;
    __device__ __forceinline__ void operator()(const f32x4 (&acc)[2][2][4][2], const Unit& u, int wr, int wc, int fr, int fq) const {
        const int row0 = u.pm * BM + wr * 64 + fr, col0 = u.pn * HALF + wc * 32 + 8 * fq;
#pragma unroll
        for (int ai = 0; ai < 2; ++ai)
#pragma unroll
            for (int m = 0; m < 4; ++m) {
                bf16_t* rowp = O + (size_t)(row0 + ai * HALF + m * 16) * ldc + col0;
                f32x4 g0 = acc[ai][0][m][0], g1 = acc[ai][0][m][1], u0 = acc[ai][1][m][0], u1 = acc[ai][1][m][1];
                if (SCALED) { const float r = rs[ai * HALF + wr * 64 + m * 16 + fr]; g0 = g0 * r; g1 = g1 * r; u0 = u0 * r; u1 = u1 * r; }
                u32x4 w;
                w.x = cvt_pk_bf16(silu_f(g0[0]) * u0[0], silu_f(g0[1]) * u0[1]); w.y = cvt_pk_bf16(silu_f(g0[2]) * u0[2], silu_f(g0[3]) * u0[3]);
                w.z = cvt_pk_bf16(silu_f(g1[0]) * u1[0], silu_f(g1[1]) * u1[1]); w.w = cvt_pk_bf16(silu_f(g1[2]) * u1[2], silu_f(g1[3]) * u1[3]);
                *(u32x4*)rowp = w;
            }
    }
};
template <bool NORM> struct EpiResid {
    static constexpr bool PERM = false, AFTER_DRAIN = false;
    const float* base; float* out; int ldc; float scale; bf16_t* xb; float* ssq;
    __device__ __forceinline__ void operator()(const f32x4 (&acc)[2][2][4][2], const Unit& u, int wr, int wc, int fr, int fq) const {
        int row0 = u.pm * BM + wr * 64 + fr, col0 = u.pn * BM + wc * 32 + 4 * fq;
        asm volatile("" : "+v"(row0), "+v"(col0));
        f32x4 b[2][2][2][2];
#pragma unroll
        for (int ch = 0; ch <= 4; ++ch) {
            if (ch < 4) {
#pragma unroll
                for (int mm = 0; mm < 2; ++mm) { const size_t off = (size_t)(row0 + (ch >> 1) * HALF + ((ch & 1) * 2 + mm) * 16) * ldc + col0;
#pragma unroll
                    for (int bj = 0; bj < 2; ++bj)
#pragma unroll
                        for (int n = 0; n < 2; ++n) b[ch & 1][mm][bj][n] = *(const f32x4*)(base + off + bj * HALF + n * 16); }
            }
            asm volatile("" ::: "memory");
            if (ch > 0) {
                const int pc = ch - 1, ai = pc >> 1;
#pragma unroll
                for (int mm = 0; mm < 2; ++mm) { const int m = (pc & 1) * 2 + mm, row = row0 + ai * HALF + m * 16; const size_t off = (size_t)row * ldc + col0;
                    float s = 0.f;
#pragma unroll
                    for (int bj = 0; bj < 2; ++bj)
#pragma unroll
                        for (int n = 0; n < 2; ++n) {
                            const f32x4 o = b[pc & 1][mm][bj][n] + acc[ai][bj][m][n] * scale;
                            *(f32x4*)(out + off + bj * HALF + n * 16) = o;
                            if (NORM) { s += (o[0] * o[0] + o[1] * o[1]) + (o[2] * o[2] + o[3] * o[3]);
                                u32x2 w; w.x = cvt_pk_bf16(o[0], o[1]); w.y = cvt_pk_bf16(o[2], o[3]); *(u32x2*)(xb + off + bj * HALF + n * 16) = w; }
                        }
                    if (NORM) { s += __shfl_xor(s, 16); s += __shfl_xor(s, 32); ssq[(size_t)row * 32 + u.pn * 4 + wc] = s; }
                }
            }
            asm volatile("" ::: "memory");
        }
    }
};
struct EpiMix {
    static constexpr bool PERM = true, AFTER_DRAIN = false;
    bf16_t *Q, *K, *V, *U, *Z, *G; const float* gbias; float* stats; const PG8_LAS float* rs;
    __device__ __forceinline__ void operator()(const f32x4 (&acc)[2][2][4][2], const Unit& u, int wr, int wc, int fr, int fq) const {
        const int pn = u.pn, row0 = u.pm * BM + wr * 64 + fr, cin = wc * 32 + 8 * fq;
        bf16_t* base; int ld, mode;
        if (pn < 4) { base = Q + pn * BM; ld = 1024; mode = 0; }
        else if (pn == 4) { base = K; ld = 256; mode = 0; }
        else if (pn == 5) { base = V; ld = 256; mode = 0; }
        else if (pn < 10) { base = U + (pn - 6) * BM; ld = 1024; mode = 1; }
        else if (pn < 14) { base = Z + (pn - 10) * BM; ld = 1024; mode = 2; }
        else { base = G + (pn - 14) * BM; ld = 4096; mode = 3; }
        f32x4 bv[2][2];
#pragma unroll
        for (int bj = 0; bj < 2; ++bj)
#pragma unroll
            for (int n = 0; n < 2; ++n) bv[bj][n] = (mode == 3) ? *(const f32x4*)(gbias + (pn - 14) * BM + cin + bj * HALF + 4 * n) : (f32x4){0.f, 0.f, 0.f, 0.f};
#pragma unroll
        for (int ai = 0; ai < 2; ++ai)
#pragma unroll
            for (int m = 0; m < 4; ++m) {
                const int row = row0 + ai * HALF + m * 16;
                bf16_t* rowp = base + (size_t)row * ld + cin;
                const float rsv = rs[ai * HALF + wr * 64 + m * 16 + fr];
                float s1 = 0.f, s2 = 0.f;
#pragma unroll
                for (int bj = 0; bj < 2; ++bj) {
                    f32x4 v0 = acc[ai][bj][m][0] * rsv + bv[bj][0], v1 = acc[ai][bj][m][1] * rsv + bv[bj][1];
                    if (mode == 1 || mode == 2) {
#pragma unroll
                        for (int e = 0; e < 4; ++e) { v0[e] = gelu_tanh_f(v0[e]); v1[e] = gelu_tanh_f(v1[e]); }
                    } else if (mode == 3) {
#pragma unroll
                        for (int e = 0; e < 4; ++e) { v0[e] = sigm(v0[e]); v1[e] = sigm(v1[e]); }
                    }
                    if (mode == 2) {
#pragma unroll
                        for (int e = 0; e < 4; ++e) { s1 += v0[e] + v1[e]; s2 += v0[e] * v0[e] + v1[e] * v1[e]; }
                    }
                    u32x4 w; w.x = cvt_pk_bf16(v0[0], v0[1]); w.y = cvt_pk_bf16(v0[2], v0[3]); w.z = cvt_pk_bf16(v1[0], v1[1]); w.w = cvt_pk_bf16(v1[2], v1[3]);
                    *(u32x4*)(rowp + bj * HALF) = w;
                }
                if (mode == 2) {
                    s1 += __shfl_xor(s1, 16); s1 += __shfl_xor(s1, 32); s2 += __shfl_xor(s2, 16); s2 += __shfl_xor(s2, 32);
                    if (fq == 0) { float* sp = stats + ((size_t)row * 16 + (pn - 10) * 4 + wc) * 2; sp[0] = s1; sp[1] = s2; }
                }
            }
    }
};
template <bool SECOND> struct EpiGate {
    static constexpr bool PERM = true, AFTER_DRAIN = false;
    const bf16_t* G; bf16_t* T;
    __device__ __forceinline__ void operator()(const f32x4 (&acc)[2][2][4][2], const Unit& u, int wr, int wc, int fr, int fq) const {
        int row0 = u.pm * BM + wr * 64 + fr, col0 = u.pn * BM + wc * 32 + 8 * fq;
        asm volatile("" : "+v"(row0), "+v"(col0));
        u32x4 gw[2][2][2], tw[2][2][2];
#pragma unroll
        for (int ch = 0; ch <= 4; ++ch) {
            if (ch < 4) {
#pragma unroll
                for (int mm = 0; mm < 2; ++mm) { const size_t row = (size_t)(row0 + (ch >> 1) * HALF + ((ch & 1) * 2 + mm) * 16);
#pragma unroll
                    for (int bj = 0; bj < 2; ++bj) { const int c = col0 + bj * HALF;
                        gw[ch & 1][mm][bj] = *(const u32x4*)(G + row * 4096 + (SECOND ? 2048 : 0) + c);
                        if (SECOND) tw[ch & 1][mm][bj] = *(const u32x4*)(T + row * 2048 + c); } }
            }
            asm volatile("" ::: "memory");
            if (ch > 0) {
                const int pc = ch - 1, ai = pc >> 1;
#pragma unroll
                for (int mm = 0; mm < 2; ++mm) { const int m = (pc & 1) * 2 + mm; const size_t row = (size_t)(row0 + ai * HALF + m * 16);
#pragma unroll
                    for (int bj = 0; bj < 2; ++bj) { const int c = col0 + bj * HALF;
                        const f32x4 a0 = acc[ai][bj][m][0], a1 = acc[ai][bj][m][1];
                        float o[8];
#pragma unroll
                        for (int e = 0; e < 4; ++e) {
                            const unsigned gwe = gw[pc & 1][mm][bj][e], twe = SECOND ? tw[pc & 1][mm][bj][e] : 0u;
                            const float glo = __uint_as_float(gwe << 16), ghi = __uint_as_float(gwe & 0xffff0000u);
                            const float tlo = __uint_as_float(twe << 16), thi = __uint_as_float(twe & 0xffff0000u);
                            const float alo = (e < 2) ? a0[2 * e] : a1[2 * e - 4], ahi = (e < 2) ? a0[2 * e + 1] : a1[2 * e - 3];
                            o[2 * e] = tlo + glo * alo; o[2 * e + 1] = thi + ghi * ahi;
                        }
                        u32x4 w; w.x = cvt_pk_bf16(o[0], o[1]); w.y = cvt_pk_bf16(o[2], o[3]); w.z = cvt_pk_bf16(o[4], o[5]); w.w = cvt_pk_bf16(o[6], o[7]);
                        *(u32x4*)(T + row * 2048 + c) = w;
                    } }
            }
            asm volatile("" ::: "memory");
        }
    }
};
}

namespace cg = cooperative_groups;
#define LAS __attribute__((address_space(3)))
typedef unsigned short bf16;
typedef float f32x4 __attribute__((ext_vector_type(4)));
typedef unsigned v4u __attribute__((ext_vector_type(4)));
typedef unsigned v2u __attribute__((ext_vector_type(2)));
typedef short bf16x8 __attribute__((ext_vector_type(8)));
typedef short s16x4 __attribute__((ext_vector_type(4)));

constexpr int NWAVES = 8;
constexpr int BATCH = 8, SEQ = 2048, D = 2048, FF = 5632, M = BATCH * SEQ;
constexpr int AW = 1024, KVW = 256, SW = 1024, NMIX = 3584 + 4096;
constexpr float EPS = 1e-6f;
constexpr size_t MiB = 1u << 20;
constexpr size_t WS_STATS = 0, WS_WSM = 2 * MiB, WS_WGU1 = 3 * MiB, WS_WD1 = 47 * MiB, WS_WGU2 = 69 * MiB, WS_WD2 = 113 * MiB, WS_WMIX = 135 * MiB,
                 WS_PA = 165 * MiB, WS_PB = 169 * MiB, WS_WOUT = 173 * MiB, WS_H = 181 * MiB, WS_ACT = 245 * MiB,
                 WS_Q = 245 * MiB, WS_K = 277 * MiB, WS_V = 285 * MiB, WS_U = 293 * MiB, WS_Z = 325 * MiB, WS_G = 357 * MiB, WS_SSQ = 485 * MiB, WS_END = 487 * MiB,
                 WS_T = WS_WGU1;
static_assert(WS_WGU1 + (size_t)2 * FF * D * 2 == WS_WD1 && WS_WD1 + (size_t)D * FF * 2 == WS_WGU2 && WS_WMIX + (size_t)NMIX * D * 2 == WS_PA && WS_H + (size_t)M * D * 2 == WS_ACT &&
              WS_ACT + (size_t)M * FF * 2 <= WS_END && WS_G + (size_t)M * 4096 * 2 == WS_SSQ && WS_T + (size_t)M * D * 2 <= WS_WGU2, "d_ws map");
constexpr size_t WS_BAR = 2 * MiB + 768 * 1024, BAR_BYTES = 16384;
constexpr int MISC_OFF = 131072 + 1024, RS_OFF = 131072 + 2048;
constexpr int LDS_BYTES = 147456;

enum { I_X = 0, I_N1, I_WG1, I_WU1, I_WD1, I_NMIX, I_WIN, I_SINK, I_LNG, I_LNB, I_WS, I_BS, I_PA, I_PB, I_WGATE, I_BGATE, I_WOUT, I_N2, I_WG2, I_WU2, I_WD2, I_NF, N_IN };

struct Args { const float* in[N_IN]; float* out; unsigned char* ws; int ph_lo, ph_hi; };

__device__ __forceinline__ unsigned f2bf(float f) { unsigned u = __builtin_bit_cast(unsigned, f); return (u + 0x7fffu + ((u >> 16) & 1u)) >> 16; }
__device__ __forceinline__ unsigned pk2(float lo, float hi) { unsigned r; asm("v_cvt_pk_bf16_f32 %0, %1, %2" : "=v"(r) : "v"(lo), "v"(hi)); return r; }
__device__ __forceinline__ float wave_sum(float v) {
#pragma unroll
    for (int o = 1; o < 64; o <<= 1) v += __shfl_xor(v, o);
    return v;
}
#define LDS_WAIT() asm volatile("s_waitcnt lgkmcnt(0)" ::: "memory")

#define XB_TMO      128
#define XB_XCNT(j)  (256  + 64 * (j))
#define XB_XSUB(j)  (1280 + 64 * (j))
#define XB_XGEN(j)  (2304 + 64 * (j))
#define XB_TOP      3328
#define XB_TOPGEN   3392
#define XCD_BAR_WORDS 3456
#define XB_SPIN_CAP (1u << 18)

__device__ __forceinline__ unsigned xb_ld(unsigned* p)              { return __hip_atomic_load(p, __ATOMIC_RELAXED, __HIP_MEMORY_SCOPE_AGENT); }
__device__ __forceinline__ unsigned xb_add(unsigned* p, unsigned v) { return __hip_atomic_fetch_add(p, v, __ATOMIC_RELAXED, __HIP_MEMORY_SCOPE_AGENT); }
__device__ __forceinline__ unsigned xb_xcc_id() { return (unsigned)__builtin_amdgcn_s_getreg((3 << 11) | 20) & 0xFu; }
#define XB_SPIN(cond, bar) do { unsigned _sp = 0; while (cond) { __builtin_amdgcn_s_sleep(1); \
    if ((++_sp & 255u) == 0u) { if (xb_ld(&(bar)[XB_TMO])) break; if (_sp > XB_SPIN_CAP) { atomicAdd(&(bar)[XB_TMO], 1u); break; } } } } while (0)

struct XcdBarrier {
    unsigned* bar; unsigned x;
    volatile LAS unsigned* st;
};

__device__ __forceinline__ XcdBarrier xcd_barrier_post(unsigned* bar, volatile LAS unsigned* st) {
    XcdBarrier b; b.bar = bar; b.x = xb_xcc_id(); b.st = st;
    if (threadIdx.x == 0) (void)xb_add(&bar[XB_XCNT(b.x)], 1u);
    return b;
}
__device__ __forceinline__ void xcd_barrier_complete(unsigned* bar, unsigned x, unsigned& nloc, unsigned& nx) {
    const unsigned G = gridDim.x * gridDim.y * gridDim.z;
    unsigned sum, cnt, mine, sp = 0u;
    for (;;) {
        sum = 0u; cnt = 0u; mine = 0u;
#pragma unroll
        for (unsigned j = 0; j < 16; ++j) { const unsigned c = xb_ld(&bar[XB_XCNT(j)]); sum += c; cnt += (c > 0u) ? 1u : 0u; mine = (j == x) ? c : mine; }
        if (sum == G) break;
        __builtin_amdgcn_s_sleep(1);
        if ((++sp & 255u) == 0u) { if (xb_ld(&bar[XB_TMO])) break; if (sp > XB_SPIN_CAP) { atomicAdd(&bar[XB_TMO], 1u); break; } }
    }
    nloc = mine > 0u ? mine : 1u; nx = cnt > 0u ? cnt : 1u;
}

__device__ __forceinline__ void xcd_barrier(const XcdBarrier& b) {
    asm volatile("s_waitcnt vmcnt(0)" ::: "memory");
    __syncthreads();
    if (threadIdx.x == 0) {
        unsigned* bar = b.bar;
        __builtin_amdgcn_s_waitcnt(0);
        unsigned nloc = b.st[0], nx = b.st[1];
        if (nloc == 0u) { xcd_barrier_complete(bar, b.x, nloc, nx); b.st[0] = nloc; b.st[1] = nx; }
        const unsigned old = xb_add(&bar[XB_XSUB(b.x)], 1u);
        const unsigned gen = old / nloc;
        if (old + 1u == (gen + 1u) * nloc) {
            __builtin_amdgcn_fence(__ATOMIC_RELEASE, "agent");
            asm volatile("s_waitcnt vmcnt(0)" ::: "memory");
            const unsigned og = xb_add(&bar[XB_TOP], 1u);
            const unsigned tg = og / nx;
            if (og + 1u == (tg + 1u) * nx) xb_add(&bar[XB_TOPGEN], 1u);
            else XB_SPIN(xb_ld(&bar[XB_TOPGEN]) == tg, bar);
            __builtin_amdgcn_fence(__ATOMIC_ACQUIRE, "agent");
            xb_add(&bar[XB_XGEN(b.x)], 1u);
            asm volatile("s_waitcnt vmcnt(0)" ::: "memory");
        } else {
            XB_SPIN(xb_ld(&bar[XB_XGEN(b.x)]) == gen, bar);
            __builtin_amdgcn_fence(__ATOMIC_ACQUIRE, "agent");
            asm volatile("s_waitcnt vmcnt(0)" ::: "memory");
        }
    }
    __syncthreads();
}

__device__ __forceinline__ void transpose_item(const float* W, int K, int N, bf16* WT, int mode, int row_off, const float* gain, int item, int lane) {
    const int nblk = N / 64, kb = item / nblk, nb = item % nblk, k0 = 64 * kb, n0 = 64 * nb;
    const int rbase = (mode == 0) ? (row_off + n0) : ((n0 >> 7) * 256 + (n0 & 127) + row_off);
    const float* src = W + (size_t)k0 * N + n0 + lane;
    float v[64];
#pragma unroll
    for (int i = 0; i < 64; ++i) v[i] = src[(size_t)i * N];
    if (gain) {
#pragma unroll
        for (int i = 0; i < 64; ++i) v[i] *= gain[k0 + i];
    }
    bf16* dst = WT + (size_t)(rbase + lane) * K + k0;
#pragma unroll
    for (int c = 0; c < 8; ++c) { v4u o; o.x = pk2(v[8 * c], v[8 * c + 1]); o.y = pk2(v[8 * c + 2], v[8 * c + 3]); o.z = pk2(v[8 * c + 4], v[8 * c + 5]); o.w = pk2(v[8 * c + 6], v[8 * c + 7]);
        *(v4u*)(dst + 8 * c) = o; }
}
template <bool OUT_BF16> __device__ __forceinline__ void rms_rows(const float* X, const float* gain, void* out, int gw, int ngw, int lane) {
    int m = gw;
    for (; m + ngw < M; m += 2 * ngw) {
        const f32x4* xr0 = (const f32x4*)(X + (size_t)m * D) + lane; const f32x4* xr1 = (const f32x4*)(X + (size_t)(m + ngw) * D) + lane;
        f32x4 v0[8], v1[8]; float s0 = 0.f, s1 = 0.f;
#pragma unroll
        for (int j = 0; j < 8; ++j) { v0[j] = xr0[64 * j]; v1[j] = xr1[64 * j]; }
#pragma unroll
        for (int j = 0; j < 8; ++j) { s0 += (v0[j].x * v0[j].x + v0[j].y * v0[j].y) + (v0[j].z * v0[j].z + v0[j].w * v0[j].w); s1 += (v1[j].x * v1[j].x + v1[j].y * v1[j].y) + (v1[j].z * v1[j].z + v1[j].w * v1[j].w); }
        const float rs0 = 1.0f / sqrtf(wave_sum(s0) * (1.0f / D) + EPS), rs1 = 1.0f / sqrtf(wave_sum(s1) * (1.0f / D) + EPS);
#pragma unroll
        for (int j = 0; j < 8; ++j) {
            const f32x4 g = ((const f32x4*)gain)[lane + 64 * j]; const f32x4 o0 = v0[j] * rs0 * g, o1 = v1[j] * rs1 * g;
            if (OUT_BF16) { v2u w0, w1; w0.x = pk2(o0.x, o0.y); w0.y = pk2(o0.z, o0.w); w1.x = pk2(o1.x, o1.y); w1.y = pk2(o1.z, o1.w);
                ((v2u*)((bf16*)out + (size_t)m * D))[lane + 64 * j] = w0; ((v2u*)((bf16*)out + (size_t)(m + ngw) * D))[lane + 64 * j] = w1; }
            else { ((f32x4*)((float*)out + (size_t)m * D))[lane + 64 * j] = o0; ((f32x4*)((float*)out + (size_t)(m + ngw) * D))[lane + 64 * j] = o1; }
        }
    }
    for (; m < M; m += ngw) {
        const f32x4* xr = (const f32x4*)(X + (size_t)m * D) + lane;
        f32x4 v[8]; float s = 0.f;
#pragma unroll
        for (int j = 0; j < 8; ++j) { v[j] = xr[64 * j]; s += (v[j].x * v[j].x + v[j].y * v[j].y) + (v[j].z * v[j].z + v[j].w * v[j].w); }
        const float rs = 1.0f / sqrtf(wave_sum(s) * (1.0f / D) + EPS);
#pragma unroll
        for (int j = 0; j < 8; ++j) {
            const f32x4 g = ((const f32x4*)gain)[lane + 64 * j]; const f32x4 o = v[j] * rs * g;
            if (OUT_BF16) { v2u w; w.x = pk2(o.x, o.y); w.y = pk2(o.z, o.w); ((v2u*)((bf16*)out + (size_t)m * D))[lane + 64 * j] = w; }
            else ((f32x4*)((float*)out + (size_t)m * D))[lane + 64 * j] = o;
        }
    }
}

constexpr int KS_LD = 72, VT_LD = 264, KS_BYTES = 256 * KS_LD * 2;
template <bool FULL> __device__ __forceinline__ void attn_qtile(const LAS bf16* Ks, const LAS bf16* Vt, const bf16* QO, bf16* Oout, int row_cur, int h, int qt, int fr, int fq, float slope8, float sink8) {
    const int qi = qt * 16 + fr, kt0 = qt < 6 ? qt : 6;
    const bf16* qrow = QO + (size_t)(row_cur + qi) * AW + h * 64; bf16* orow = Oout + (size_t)(row_cur + qi) * AW + h * 64;
    bf16x8 qf[2]; qf[0] = *(const bf16x8*)(qrow + fq * 8); qf[1] = *(const bf16x8*)(qrow + 32 + fq * 8);
    const int d0 = 128 + qi - kt0 * 16 - fq * 4;
    const int e0 = 128 - kt0 * 16 - fq * 4;
    const float a0 = -slope8 * (float)d0;
    f32x4 S[10];
#pragma unroll
    for (int j = 0; j < 10; ++j) {
#pragma unroll
        for (int i = 0; i < 4; ++i) S[j][i] = fmaf(slope8, (float)(16 * j + i), a0);
#pragma unroll
        for (int ks = 0; ks < 2; ++ks) {
            const bf16x8 kf = *(const LAS bf16x8*)(Ks + ((kt0 + j) * 16 + fr) * KS_LD + ks * 32 + fq * 8);
            S[j] = __builtin_amdgcn_mfma_f32_16x16x32_bf16(kf, qf[ks], S[j], 0, 0, 0);
        }
    }
    float mx = sink8;
#pragma unroll
    for (int j = 0; j < 10; ++j)
#pragma unroll
        for (int i = 0; i < 4; ++i) {
            if (FULL || j < 2 || j > 7) {
                const int c = 16 * j + i; bool ok = (unsigned)(d0 - c) < 128u; if (FULL) ok = ok && (c >= e0);
                S[j][i] = ok ? S[j][i] : -1e30f;
            }
            mx = fmaxf(mx, S[j][i]);
        }
    mx = fmaxf(mx, __shfl_xor(mx, 16)); mx = fmaxf(mx, __shfl_xor(mx, 32));
    const float C = 0.125f * 1.4426950409f, nm = -mx * C;
    float sum = 0.f;
#pragma unroll
    for (int j = 0; j < 10; ++j)
#pragma unroll
        for (int i = 0; i < 4; ++i) { const float p = __builtin_amdgcn_exp2f(fmaf(S[j][i], C, nm)); S[j][i] = p; sum += p; }
    sum += __shfl_xor(sum, 16); sum += __shfl_xor(sum, 32);
    sum += __builtin_amdgcn_exp2f(fmaf(sink8, C, nm));
    const float inv = 1.0f / sum;
    f32x4 O[4];
#pragma unroll
    for (int dt = 0; dt < 4; ++dt) O[dt] = (f32x4){0.f, 0.f, 0.f, 0.f};
#pragma unroll
    for (int kk = 0; kk < 5; ++kk) {
        v4u pw; pw.x = pk2(S[2 * kk][0], S[2 * kk][1]); pw.y = pk2(S[2 * kk][2], S[2 * kk][3]); pw.z = pk2(S[2 * kk + 1][0], S[2 * kk + 1][1]); pw.w = pk2(S[2 * kk + 1][2], S[2 * kk + 1][3]);
        const bf16x8 pb = __builtin_bit_cast(bf16x8, pw);
#pragma unroll
        for (int dt = 0; dt < 4; ++dt) {
            const LAS bf16* vp = Vt + (dt * 16 + fr) * VT_LD + (kt0 + 2 * kk) * 16 + fq * 4;
            const v2u a0v = *(const LAS v2u*)vp, a1v = *(const LAS v2u*)(vp + 16);
            v4u aw; aw.x = a0v.x; aw.y = a0v.y; aw.z = a1v.x; aw.w = a1v.y;
            O[dt] = __builtin_amdgcn_mfma_f32_16x16x32_bf16(__builtin_bit_cast(bf16x8, aw), pb, O[dt], 0, 0, 0);
        }
    }
#pragma unroll
    for (int dt = 0; dt < 4; ++dt) { v2u w; w.x = pk2(O[dt][0] * inv, O[dt][1] * inv); w.y = pk2(O[dt][2] * inv, O[dt][3] * inv); *(v2u*)(orow + dt * 16 + fq * 4) = w; }
}

__device__ __forceinline__ void attn_unit(LAS unsigned char* lds, const bf16* QO, bf16* Oout, const bf16* Kb, const bf16* Vb, const float* sinks, int unit, int tid, int wave, int lane) {
    const int b = unit >> 6, blk = (unit >> 2) & 15, kvh = unit & 3;
    const int row_cur = b * SEQ + blk * 128;
    LAS bf16* Ks = (LAS bf16*)lds; LAS bf16* Vt = (LAS bf16*)(lds + KS_BYTES);
    __syncthreads();
#pragma unroll
    for (int i = 0; i < 4; ++i) {
        const int idx = tid + i * 512, key = idx >> 3, ch = idx & 7; const bool ok = (blk > 0) || (key >= 128);
        v4u v = (v4u){0u, 0u, 0u, 0u}; if (ok) v = *(const v4u*)(Kb + (size_t)(row_cur - 128 + key) * KVW + kvh * 64 + ch * 8);
        *(LAS v4u*)(Ks + key * KS_LD + ch * 8) = v;
    }
#pragma unroll
    for (int i = 0; i < 4; ++i) {
        const int idx = tid + i * 512, key = idx & 255, ch = idx >> 8; const bool ok = (blk > 0) || (key >= 128);
        v4u v = (v4u){0u, 0u, 0u, 0u}; if (ok) v = *(const v4u*)(Vb + (size_t)(row_cur - 128 + key) * KVW + kvh * 64 + ch * 8);
#pragma unroll
        for (int e = 0; e < 4; ++e) { Vt[(ch * 8 + 2 * e) * VT_LD + key] = (bf16)(v[e] & 0xffffu); Vt[(ch * 8 + 2 * e + 1) * VT_LD + key] = (bf16)(v[e] >> 16); }
    }
    __syncthreads();
    const int h = kvh * 4 + (wave >> 1), fr = lane & 15, fq = lane >> 4;
    const float slope8 = 8.0f * __builtin_amdgcn_exp2f(-0.5f * (float)(h + 1)), sink8 = 8.0f * sinks[h];
    if (blk == 0) { for (int qq = 0; qq < 4; ++qq) attn_qtile<true>(Ks, Vt, QO, Oout, row_cur, h, (wave & 1) * 4 + qq, fr, fq, slope8, sink8); }
    else          { for (int qq = 0; qq < 4; ++qq) attn_qtile<false>(Ks, Vt, QO, Oout, row_cur, h, (wave & 1) * 4 + qq, fr, fq, slope8, sink8); }
}

constexpr int ZT_LD = 136, ZT_BYTES = 256 * ZT_LD * 2;
__device__ __forceinline__ void sgu_unit(LAS unsigned char* lds, const bf16* U, bf16* Uout, const bf16* Zb, const float* stats, const float* lng, const float* lnb, const bf16* wsm, const float* bs,
                                         int unit, int tid, int wave, int lane) {
    const int b = unit >> 6, chunk = (unit >> 2) & 15, gq = unit & 3;
    const int row0 = b * SEQ + chunk * 128, colbase = gq * 256;
    LAS bf16* zt = (LAS bf16*)lds; LAS float* st = (LAS float*)(lds + ZT_BYTES);
    __syncthreads();
    if (tid < 128) {
        const f32x4* sp = (const f32x4*)(stats + (size_t)(row0 + tid) * 32); float s1 = 0.f, s2 = 0.f;
#pragma unroll
        for (int p = 0; p < 8; ++p) { const f32x4 v = sp[p]; s1 += v.x + v.z; s2 += v.y + v.w; }
        const float mu = s1 * (1.0f / SW), var = fmaxf(s2 * (1.0f / SW) - mu * mu, 0.f);
        st[2 * tid] = mu; st[2 * tid + 1] = 1.0f / sqrtf(var + EPS);
    }
    __syncthreads();
#pragma unroll 2
    for (int i = 0; i < 8; ++i) {
        const int idx = tid + i * 512, s = idx & 127, c8 = idx >> 7;
        const v4u z = *(const v4u*)(Zb + (size_t)(row0 + s) * SW + colbase + c8 * 8);
        const float mu = st[2 * s], rstd = st[2 * s + 1];
        const float* gp = lng + colbase + c8 * 8; const float* bp = lnb + colbase + c8 * 8;
#pragma unroll
        for (int e = 0; e < 4; ++e) {
            const float zlo = __uint_as_float(z[e] << 16), zhi = __uint_as_float(z[e] & 0xffff0000u);
            const unsigned zp = pk2((zlo - mu) * rstd * gp[2 * e] + bp[2 * e], (zhi - mu) * rstd * gp[2 * e + 1] + bp[2 * e + 1]);
            zt[(c8 * 8 + 2 * e) * ZT_LD + s] = (bf16)(zp & 0xffffu);
            zt[(c8 * 8 + 2 * e + 1) * ZT_LD + s] = (bf16)(zp >> 16);
        }
    }
    __syncthreads();
    const int fr = lane & 15, fq = lane >> 4, t = wave * 16 + fr, nks = (wave >> 1) + 1;
    f32x4 acc[16];
#pragma unroll
    for (int ct = 0; ct < 16; ++ct) acc[ct] = (f32x4){0.f, 0.f, 0.f, 0.f};
    for (int ks = 0; ks < nks; ++ks) {
        bf16x8 wb[4];
#pragma unroll
        for (int gi = 0; gi < 4; ++gi) wb[gi] = *(const bf16x8*)(wsm + ((size_t)((gq * 4 + gi) * 128 + t)) * 128 + ks * 32 + fq * 8);
#pragma unroll
        for (int ct = 0; ct < 16; ++ct) {
            const bf16x8 za = *(const LAS bf16x8*)(zt + (ct * 16 + fr) * ZT_LD + ks * 32 + fq * 8);
            acc[ct] = __builtin_amdgcn_mfma_f32_16x16x32_bf16(za, wb[ct >> 2], acc[ct], 0, 0, 0);
        }
    }
    const bf16* urow = U + (size_t)(row0 + t) * SW + colbase + fq * 4; bf16* uorow = Uout + (size_t)(row0 + t) * SW + colbase + fq * 4;
#pragma unroll
    for (int ct = 0; ct < 16; ++ct) {
        const float bias = bs[(gq * 4 + (ct >> 2)) * 128 + t];
        const v2u uw = *(const v2u*)(urow + ct * 16);
        const float u0 = __uint_as_float(uw.x << 16), u1 = __uint_as_float(uw.x & 0xffff0000u), u2 = __uint_as_float(uw.y << 16), u3 = __uint_as_float(uw.y & 0xffff0000u);
        v2u w; w.x = pk2(u0 * (acc[ct][0] + bias), u1 * (acc[ct][1] + bias)); w.y = pk2(u2 * (acc[ct][2] + bias), u3 * (acc[ct][3] + bias));
        *(v2u*)(uorow + ct * 16) = w;
    }
}

__device__ __forceinline__ void panel_scales(LAS unsigned char* lds, const float* ssq, int pm, int tid) {
    const int r = tid >> 1, h = tid & 1;
    const f32x4* p = (const f32x4*)(ssq + (size_t)(pm * 256 + r) * 32 + h * 16);
    const f32x4 a = p[0], b = p[1], c = p[2], d = p[3];
    float sum = (((a.x + a.y) + (a.z + a.w)) + ((b.x + b.y) + (b.z + b.w))) + (((c.x + c.y) + (c.z + c.w)) + ((d.x + d.y) + (d.z + d.w)));
    sum += __shfl_xor(sum, 1);
    if (h == 0) ((LAS float*)(lds + RS_OFF))[r] = 1.0f / sqrtf(sum * (1.0f / D) + EPS);
    __syncthreads();
}

#ifndef MK_N_LAUNCHES
#define MK_N_LAUNCHES 1
#endif
constexpr int N_PHASES = 12;
constexpr int IT_FF = (D / 64) * (FF / 64), IT_DN = (FF / 64) * (D / 64), IT_WIN = (D / 64) * (3584 / 64), IT_WG = (D / 64) * (4096 / 64), IT_P = (AW / 64) * (D / 64), IT_O = (D / 64) * (D / 64);
constexpr int N_EARLY = 2 * IT_FF + IT_DN + IT_WIN + IT_WG, N_LATE = 2 * IT_P + IT_O + 2 * IT_FF + IT_DN;
static_assert(N_LATE % 8 == 0, "late items are dealt over 8 queue heads");

__global__ void __launch_bounds__(NWAVES * 64, 2) hybrid_fwd(Args args) {
    extern __shared__ __attribute__((aligned(16))) unsigned char lds_raw[];
    LAS unsigned char* lds = (LAS unsigned char*)lds_raw;
    const int tid = threadIdx.x, lane = tid & 63, wave = __builtin_amdgcn_readfirstlane(tid >> 6);
    const int G = gridDim.x, gw = blockIdx.x * NWAVES + wave, ngw = G * NWAVES;
    unsigned char* ws = args.ws;
    const int lo = args.ph_lo, hi = args.ph_hi;
#define IN(k) (lo <= (k) && (k) < hi)
    if (tid < 64) ((LAS unsigned*)(lds + MISC_OFF))[tid] = 0u;
    __syncthreads();
    XcdBarrier bar; bar.bar = (unsigned*)(ws + WS_BAR); bar.x = 0; bar.st = (volatile LAS unsigned*)(lds + MISC_OFF + 32);
    if (hi - lo > 1) bar = xcd_barrier_post((unsigned*)(ws + WS_BAR), (volatile LAS unsigned*)(lds + MISC_OFF + 32));
#define SEAM(k) do { if (IN(k) && IN((k) + 1)) xcd_barrier(bar); } while (0)
    if (lo < 0) cg::this_grid().sync();
    bf16* Hb = (bf16*)(ws + WS_H); bf16* ACT = (bf16*)(ws + WS_ACT); bf16* Tb = (bf16*)(ws + WS_T); float* ssq = (float*)(ws + WS_SSQ);
    bf16 *Qb = (bf16*)(ws + WS_Q), *Kb = (bf16*)(ws + WS_K), *Vb = (bf16*)(ws + WS_V), *Ub = (bf16*)(ws + WS_U), *Zb = (bf16*)(ws + WS_Z), *Gb = (bf16*)(ws + WS_G);
    float* stats = (float*)(ws + WS_STATS); bf16* wsm = (bf16*)(ws + WS_WSM);

    if (IN(0)) {
        for (int it = gw; it < N_EARLY; it += ngw) {
            int r = it;
            if (r < IT_FF) { transpose_item(args.in[I_WG1], D, FF, (bf16*)(ws + WS_WGU1), 1, 0, nullptr, r, lane); continue; } r -= IT_FF;
            if (r < IT_FF) { transpose_item(args.in[I_WU1], D, FF, (bf16*)(ws + WS_WGU1), 1, 128, nullptr, r, lane); continue; } r -= IT_FF;
            if (r < IT_DN) { transpose_item(args.in[I_WD1], FF, D, (bf16*)(ws + WS_WD1), 0, 0, nullptr, r, lane); continue; } r -= IT_DN;
            if (r < IT_WIN) { transpose_item(args.in[I_WIN], D, 3584, (bf16*)(ws + WS_WMIX), 0, 0, args.in[I_NMIX], r, lane); continue; } r -= IT_WIN;
            transpose_item(args.in[I_WGATE], D, 4096, (bf16*)(ws + WS_WMIX), 0, 3584, args.in[I_NMIX], r, lane);
        }
        for (int e = blockIdx.x * 512 + tid; e < 16 * 128 * 128; e += G * 512) { const int s = e & 127, t = (e >> 7) & 127; wsm[e] = (s <= t) ? (bf16)f2bf(args.in[I_WS][e]) : (bf16)0; }
        rms_rows<true>(args.in[I_X], args.in[I_N1], Hb, gw, ngw, lane);
    }
    SEAM(0);
    if (IN(1)) {
        pg8::Gemm g{Hb, (const bf16*)(ws + WS_WGU1), M, 2 * FF, D}; pg8::StaticOrder S; S.init(M, 2 * FF, G, (int)blockIdx.x);
        pg8::EpiSwiGLU<false> E{ACT, FF, nullptr};
        pg8::gemm_phase<pg8::EpiSwiGLU<false>, pg8::StaticOrder, true, true>(lds, g, S, E);
    }
    SEAM(1);
    if (IN(2)) {
        pg8::Gemm g{ACT, (const bf16*)(ws + WS_WD1), M, D, FF}; pg8::StaticOrder S; S.init(M, D, G, (int)blockIdx.x);
        pg8::EpiResid<true> E{args.in[I_X], args.out, D, 0.5f, Hb, ssq};
        pg8::gemm_phase<pg8::EpiResid<true>, pg8::StaticOrder, true, true>(lds, g, S, E);
    }
    SEAM(2);
    if (IN(4)) {
        pg8::Gemm g{Hb, (const bf16*)(ws + WS_WMIX), M, NMIX, D}; pg8::StaticOrder S; S.init(M, NMIX, G, (int)blockIdx.x);
        { pg8::Unit u0; if (S.next(0, u0)) panel_scales(lds, ssq, u0.pm, tid); else __syncthreads(); }
        pg8::EpiMix E{Qb, Kb, Vb, Ub, Zb, Gb, args.in[I_BGATE], stats, (const LAS float*)(lds + RS_OFF)};
        pg8::gemm_phase<pg8::EpiMix, pg8::StaticOrder, true, true>(lds, g, S, E);
        unsigned* qheads = (unsigned*)(ws + WS_BAR + 14336);
        const int myq = (int)(xb_xcc_id() & 7u);
        for (int q = 0; q < 8; ++q) {
            const int qi = (myq + q) & 7;
            for (;;) {
                int t = 0;
                if (lane == 0) t = (int)__hip_atomic_fetch_add(qheads + 64 * qi, 1u, __ATOMIC_RELAXED, __HIP_MEMORY_SCOPE_AGENT);
                t = __builtin_amdgcn_readfirstlane(t);
                if (t >= N_LATE / 8) break;
                int r = t * 8 + qi;
                if (r < IT_P) { transpose_item(args.in[I_PA], AW, D, (bf16*)(ws + WS_PA), 0, 0, nullptr, r, lane); continue; } r -= IT_P;
                if (r < IT_P) { transpose_item(args.in[I_PB], SW, D, (bf16*)(ws + WS_PB), 0, 0, nullptr, r, lane); continue; } r -= IT_P;
                if (r < IT_O) { transpose_item(args.in[I_WOUT], D, D, (bf16*)(ws + WS_WOUT), 0, 0, nullptr, r, lane); continue; } r -= IT_O;
                if (r < IT_FF) { transpose_item(args.in[I_WG2], D, FF, (bf16*)(ws + WS_WGU2), 1, 0, args.in[I_N2], r, lane); continue; } r -= IT_FF;
                if (r < IT_FF) { transpose_item(args.in[I_WU2], D, FF, (bf16*)(ws + WS_WGU2), 1, 128, args.in[I_N2], r, lane); continue; } r -= IT_FF;
                transpose_item(args.in[I_WD2], FF, D, (bf16*)(ws + WS_WD2), 0, 0, nullptr, r, lane);
            }
        }
    }
    SEAM(4);
    if (IN(5)) {
        for (int i = blockIdx.x; i < 1024; i += G) {
            if (i < 512) attn_unit(lds, Qb, Qb, Kb, Vb, args.in[I_SINK], i, tid, wave, lane);
            else sgu_unit(lds, Ub, Ub, Zb, stats, args.in[I_LNG], args.in[I_LNB], wsm, args.in[I_BS], i - 512, tid, wave, lane);
        }
        __syncthreads();
    }
    SEAM(5);
    if (IN(6)) {
        { pg8::Gemm g{Qb, (const bf16*)(ws + WS_PA), M, D, AW}; pg8::StaticOrder S; S.init(M, D, G, (int)blockIdx.x);
          pg8::EpiGate<false> E{Gb, Tb}; pg8::gemm_phase<pg8::EpiGate<false>, pg8::StaticOrder, true, true>(lds, g, S, E); }
        { pg8::Gemm g{Ub, (const bf16*)(ws + WS_PB), M, D, SW}; pg8::StaticOrder S; S.init(M, D, G, (int)blockIdx.x);
          pg8::EpiGate<true> E{Gb, Tb}; pg8::gemm_phase<pg8::EpiGate<true>, pg8::StaticOrder, true, true>(lds, g, S, E); }
    }
    SEAM(6);
    if (IN(7)) {
        pg8::Gemm g{Tb, (const bf16*)(ws + WS_WOUT), M, D, D}; pg8::StaticOrder S; S.init(M, D, G, (int)blockIdx.x);
        pg8::EpiResid<true> E{args.out, args.out, D, 1.0f, Hb, ssq};
        pg8::gemm_phase<pg8::EpiResid<true>, pg8::StaticOrder, true, true>(lds, g, S, E);
    }
    SEAM(7);
    if (IN(9)) {
        pg8::Gemm g{Hb, (const bf16*)(ws + WS_WGU2), M, 2 * FF, D}; pg8::StaticOrder S; S.init(M, 2 * FF, G, (int)blockIdx.x);
        { pg8::Unit u0; if (S.next(0, u0)) panel_scales(lds, ssq, u0.pm, tid); else __syncthreads(); }
        pg8::EpiSwiGLU<true> E{ACT, FF, (const LAS float*)(lds + RS_OFF)};
        pg8::gemm_phase<pg8::EpiSwiGLU<true>, pg8::StaticOrder, true, true>(lds, g, S, E);
    }
    SEAM(9);
    if (IN(10)) {
        pg8::Gemm g{ACT, (const bf16*)(ws + WS_WD2), M, D, FF}; pg8::StaticOrder S; S.init(M, D, G, (int)blockIdx.x);
        pg8::EpiResid<false> E{args.out, args.out, D, 0.5f, nullptr, nullptr};
        pg8::gemm_phase<pg8::EpiResid<false>, pg8::StaticOrder, true, true>(lds, g, S, E);
    }
    SEAM(10);
    if (IN(11)) rms_rows<false>(args.out, args.in[I_NF], args.out, gw, ngw, lane);
#undef IN
#undef SEAM
}

extern "C" void kernel_launch(void* const* d_in, const int* in_sizes, int n_in, void* d_out, int out_size, void* d_ws, size_t ws_size, hipStream_t stream) {
    static int grid = 0;
    if (grid == 0) {
        if (n_in != N_IN || in_sizes[0] != M * D || out_size != M * D || ws_size < WS_END) { fprintf(stderr, "kernel_launch: unexpected shapes (n_in %d, in0 %d, out %d, ws %zu)\n", n_in, n_in > 0 ? in_sizes[0] : -1, out_size, ws_size); grid = -1; return; }
        int dev = 0, cus = 0, per_cu = 0;
        if (hipGetDevice(&dev) != hipSuccess || hipDeviceGetAttribute(&cus, hipDeviceAttributeMultiprocessorCount, dev) != hipSuccess) { grid = -1; return; }
        if (hipFuncSetAttribute((const void*)hybrid_fwd, hipFuncAttributeMaxDynamicSharedMemorySize, LDS_BYTES) != hipSuccess) { fprintf(stderr, "kernel_launch: hipFuncSetAttribute failed\n"); grid = -1; return; }
        if (hipOccupancyMaxActiveBlocksPerMultiprocessor(&per_cu, (const void*)hybrid_fwd, NWAVES * 64, LDS_BYTES) != hipSuccess || per_cu < 1) { fprintf(stderr, "kernel_launch: occupancy query says %d\n", per_cu); per_cu = 1; }
        (void)hipGetLastError();
        grid = (cus / 64) * 64;
        if (grid < 64) { fprintf(stderr, "kernel_launch: needs at least 64 CUs\n"); grid = -1; return; }
        (void)per_cu;
    }
    if (grid < 0) return;
    if (hipMemsetAsync((char*)d_ws + WS_BAR, 0, BAR_BYTES, stream) != hipSuccess) { fprintf(stderr, "kernel_launch: memset failed\n"); return; }
    Args a{};
    for (int i = 0; i < N_IN; ++i) a.in[i] = (const float*)d_in[i];
    a.out = (float*)d_out; a.ws = (unsigned char*)d_ws;
#if MK_N_LAUNCHES == 1
    a.ph_lo = 0; a.ph_hi = N_PHASES;
    void* kargs[] = {&a};
    hipError_t e = hipLaunchCooperativeKernel((const void*)hybrid_fwd, dim3(grid), dim3(NWAVES * 64), kargs, LDS_BYTES, stream);
    if (e != hipSuccess) fprintf(stderr, "kernel_launch: cooperative launch failed: %s (grid %d)\n", hipGetErrorString(e), grid);
#else
    for (int p = 0; p < N_PHASES; ++p) {
        a.ph_lo = p; a.ph_hi = p + 1;
        hipLaunchKernelGGL(hybrid_fwd, dim3(grid), dim3(NWAVES * 64), LDS_BYTES, stream, a);
    }
#endif
}
```

```cpp
#include <hip/hip_runtime.h>
#include <hip/hip_cooperative_groups.h>
#include <cstdio>
#include <cstdint>
namespace pg8 {
#define PG8_LAS __attribute__((address_space(3)))
typedef unsigned short bf16_t;
typedef short bf16x8 __attribute__((ext_vector_type(8)));
typedef float f32x4 __attribute__((ext_vector_type(4)));
typedef unsigned u32x4 __attribute__((ext_vector_type(4)));
constexpr int BM = 256, BK = 64, HALF = 128, HTB = HALF * BK * 2  , STAGE_BYTES = 8 * HTB, NXCD = 8, WGM = 8;

__host__ __device__ __forceinline__ int lds_byte(int r, int c) { const int st = (r >> 4) * 2 + (c >> 5), rr = r & 15, cc = c & 31, ob = rr * 64 + cc * 2; return st * 1024 + (ob ^ (((ob >> 9) & 1) << 5)); }
__host__ __device__ __forceinline__ void stage_rc(int b, int& R, int& C) { const int st = b / 1024, sb = b % 1024, swz = sb ^ (((sb >> 9) & 1) << 5); R = (st >> 1) * 16 + swz / 64; C = (st & 1) * 32 + (swz % 64) / 2; }
__host__ __device__ __forceinline__ int perm32(int rho) { const int n = rho >> 4, i = rho & 15; return 8 * (i >> 2) + 4 * n + (i & 3); }

struct Unit { int pm, pn; };
struct Gemm { const bf16_t* A; const bf16_t* Bt; int M, N, K; };

struct StaticOrder {
    int nM, nN, nwg, G, c;
    __host__ __device__ void init(int M, int N, int G_, int c_) { nM = M / BM; nN = N / BM; nwg = nM * nN; G = G_; c = c_; }
    __host__ __device__ bool next(int i, Unit& u) const {
        const long L = (long)i * G + c; if (L >= nwg) return false;
        int wgid = (int)L; { const int q = nwg / NXCD, r = nwg % NXCD, xcd = wgid % NXCD, off = wgid / NXCD; wgid = (xcd < r ? xcd * (q + 1) : r * (q + 1) + (xcd - r) * q) + off; }
        const int nig = WGM * nN, gid = wgid / nig, fm = gid * WGM, gsz = (nM - fm) < WGM ? (nM - fm) : WGM;
        u.pm = fm + ((wgid % nig) % gsz); u.pn = (wgid % nig) / gsz; return true;
    }
    __device__ __forceinline__ void a_ready(const Unit&) const {}
    __device__ __forceinline__ void done(const Unit&) const {}
};

__device__ __forceinline__ unsigned cvt_pk_bf16(float lo, float hi) { typedef float f2_t __attribute__((ext_vector_type(2))); typedef __bf16 b2_t __attribute__((ext_vector_type(2))); const f2_t v = {lo, hi}; return __builtin_bit_cast(unsigned, __builtin_convertvector(v, b2_t)); }
template <class Epi, class Sched, bool ALIGN_EPI = false, bool SP2 = false>
__device__ __forceinline__ void gemm_phase(PG8_LAS unsigned char* lds, const Gemm g, const Sched& S, const Epi& E) {
    const int tid = threadIdx.x, wid = __builtin_amdgcn_readfirstlane(tid >> 6), lane = tid & 63, wr = wid >> 2, wc = wid & 3, fr = lane & 15, fq = lane >> 4;
    const int K = g.K, nt = K / BK;
    unsigned voffA[2], voffB[2];
#pragma unroll
    for (int i = 0; i < 2; ++i) { int R, C; stage_rc(tid * 16 + i * 8192, R, C); const int Rb = Epi::PERM ? ((R & ~31) + perm32(R & 31)) : R;
        voffA[i] = (unsigned)(R * K + C) * 2u; voffB[i] = (unsigned)(Rb * K + C) * 2u; }
    const size_t kstep = (size_t)(BK * 2);
    const size_t hstep = (size_t)HALF * K * 2;
    const size_t tstep = 2 * hstep;
    const unsigned ldsw = (unsigned)wid * 1024u;
    const int aoff = lds_byte(wr * 64 + fr, fq * 8), boff = lds_byte(wc * 32 + fr, fq * 8);
    const __amdgpu_buffer_rsrc_t rsrc_voffA = __builtin_amdgcn_make_buffer_rsrc((void*)g.A, 0, 0x7ffffff0, 0x00020000), rsrc_voffB = __builtin_amdgcn_make_buffer_rsrc((void*)g.Bt, 0, 0x7ffffff0, 0x00020000);
    const char* const base_voffA = (const char*)g.A; const char* const base_voffB = (const char*)g.Bt;
#define PG8_SA(b, h) (((b) * 2 + (h)) * HTB)
#define PG8_SB(b, h) ((4 + (b) * 2 + (h)) * HTB)
#define PG8_STAGE(bufoff, gbase, voff) do { const int _so = (int)((const char*)(gbase) - base_##voff); _Pragma("unroll") for (int _i = 0; _i < 2; ++_i) \
        __builtin_amdgcn_raw_ptr_buffer_load_lds(rsrc_##voff, (PG8_LAS unsigned*)(lds + (bufoff) + ldsw + _i * 8192), 16, (int)(voff)[_i], _so, 0, 0); } while (0)
#define PG8_LDA(dst, b, h) do { _Pragma("unroll") for (int m = 0; m < 4; ++m) _Pragma("unroll") for (int k = 0; k < 2; ++k) dst[m][k] = *(const PG8_LAS bf16x8*)(lds + PG8_SA(b, h) + aoff + m * 2048 + k * 1024); } while (0)
#define PG8_LDB(dst, b, h) do { _Pragma("unroll") for (int n = 0; n < 2; ++n) _Pragma("unroll") for (int k = 0; k < 2; ++k) dst[n][k] = *(const PG8_LAS bf16x8*)(lds + PG8_SB(b, h) + boff + n * 2048 + k * 1024); } while (0)
#define PG8_MMA(ai, bj, At, Bt) do { __builtin_amdgcn_s_setprio(1); _Pragma("unroll") for (int m = 0; m < 4; ++m) _Pragma("unroll") for (int n = 0; n < 2; ++n) _Pragma("unroll") for (int k = 0; k < 2; ++k) \
        acc[ai][bj][m][n] = __builtin_amdgcn_mfma_f32_16x16x32_bf16(Bt[n][k], At[m][k], acc[ai][bj][m][n], 0, 0, 0); __builtin_amdgcn_s_setprio(0); } while (0)
#define PG8_WAIT_V(n) asm volatile("s_waitcnt vmcnt(" #n ")" ::: "memory")
#define PG8_WAIT_L(n) asm volatile("s_waitcnt lgkmcnt(" #n ")" ::: "memory")
#define PG8_BAR __builtin_amdgcn_s_barrier()
#define PG8_SCHED __builtin_amdgcn_sched_barrier(0)
    Unit cur, nxt; int ui = 0;
    if (!S.next(0, cur)) return;
    f32x4 acc[2][2][4][2];
#pragma unroll
    for (int a = 0; a < 2; ++a)
#pragma unroll
        for (int b = 0; b < 2; ++b)
#pragma unroll
            for (int m = 0; m < 4; ++m)
#pragma unroll
                for (int n = 0; n < 2; ++n) acc[a][b][m][n] = (f32x4){0.f, 0.f, 0.f, 0.f};
    bf16x8 At[4][2], B0[2][2], B1[2][2];
    const char* cA = (const char*)g.A + (size_t)cur.pm * tstep; const char* cB = (const char*)g.Bt + (size_t)cur.pn * tstep;
    S.a_ready(cur);
    if constexpr (SP2) {
        PG8_STAGE(PG8_SB(0, 0), cB, voffB); PG8_STAGE(PG8_SB(0, 1), cB + hstep, voffB); PG8_STAGE(PG8_SA(0, 0), cA, voffA); PG8_STAGE(PG8_SA(0, 1), cA + hstep, voffA);
        if (wr == 1) PG8_BAR;
        PG8_WAIT_V(2); PG8_BAR;
        PG8_STAGE(PG8_SB(1, 0), cB + kstep, voffB); PG8_STAGE(PG8_SA(1, 0), cA + kstep, voffA); PG8_STAGE(PG8_SB(1, 1), cB + hstep + kstep, voffB);
        PG8_WAIT_V(6); PG8_BAR;
    } else {
        PG8_STAGE(PG8_SB(0, 0), cB, voffB); PG8_STAGE(PG8_SA(0, 0), cA, voffA); PG8_STAGE(PG8_SB(0, 1), cB + hstep, voffB); PG8_STAGE(PG8_SA(0, 1), cA + hstep, voffA);
        if (wr == 1) PG8_BAR;
        PG8_WAIT_V(4); PG8_BAR;
        PG8_STAGE(PG8_SB(1, 0), cB + kstep, voffB); PG8_STAGE(PG8_SA(1, 0), cA + kstep, voffA); PG8_STAGE(PG8_SB(1, 1), cB + hstep + kstep, voffB);
        PG8_WAIT_V(6); PG8_BAR;
    }
    for (;;) {
        const bool has_next = S.next(ui + 1, nxt);
        const char* nA = has_next ? (const char*)g.A + (size_t)nxt.pm * tstep : cA; const char* nB = has_next ? (const char*)g.Bt + (size_t)nxt.pn * tstep : cB;
        for (int t = 0; t < nt; t += 2) {
            const bool last = (t == nt - 2);
            const char* a1 = cA + (size_t)(t + 1) * kstep;
            const char* a2 = last ? nA : cA + (size_t)(t + 2) * kstep; const char* b2 = last ? nB : cB + (size_t)(t + 2) * kstep;
            const char* a3 = a2 + kstep; const char* b3 = b2 + kstep;
            if (last && has_next) S.a_ready(nxt);
            if constexpr (SP2) {
            PG8_LDB(B0, 0, 0); PG8_LDB(B1, 0, 1); PG8_SCHED; PG8_LDA(At, 0, 0); PG8_STAGE(PG8_SA(1, 1), a1 + hstep, voffA);
            PG8_WAIT_V(8); PG8_WAIT_L(0); PG8_BAR; PG8_MMA(0, 0, At, B0); PG8_MMA(0, 1, At, B1); PG8_BAR; PG8_SCHED;
            PG8_LDA(At, 0, 1); PG8_STAGE(PG8_SB(0, 0), b2, voffB); PG8_STAGE(PG8_SB(0, 1), b2 + hstep, voffB); PG8_STAGE(PG8_SA(0, 0), a2, voffA);
            PG8_WAIT_V(8); PG8_WAIT_L(0); PG8_BAR; PG8_MMA(1, 0, At, B0); PG8_MMA(1, 1, At, B1); PG8_BAR; PG8_SCHED;
            PG8_LDB(B0, 1, 0); PG8_LDB(B1, 1, 1); PG8_SCHED; PG8_LDA(At, 1, 0); PG8_STAGE(PG8_SA(0, 1), a2 + hstep, voffA);
            PG8_WAIT_V(8); PG8_WAIT_L(0); PG8_BAR; PG8_MMA(0, 0, At, B0); PG8_MMA(0, 1, At, B1); PG8_BAR; PG8_SCHED;
            PG8_LDA(At, 1, 1); PG8_STAGE(PG8_SB(1, 0), b3, voffB); PG8_STAGE(PG8_SB(1, 1), b3 + hstep, voffB); PG8_STAGE(PG8_SA(1, 0), a3, voffA);
            PG8_WAIT_V(8); PG8_WAIT_L(0); PG8_BAR; PG8_MMA(1, 0, At, B0); PG8_MMA(1, 1, At, B1); PG8_BAR; PG8_SCHED;
            } else {
            PG8_LDB(B0, 0, 0); PG8_SCHED; PG8_LDA(At, 0, 0); PG8_STAGE(PG8_SA(1, 1), a1 + hstep, voffA);
            PG8_WAIT_L(8); PG8_BAR; PG8_WAIT_L(0); PG8_MMA(0, 0, At, B0); PG8_BAR; PG8_SCHED;
            PG8_LDB(B1, 0, 1); PG8_STAGE(PG8_SB(0, 0), b2, voffB);
            PG8_BAR; PG8_WAIT_L(0); PG8_MMA(0, 1, At, B1); PG8_BAR;
            PG8_LDA(At, 0, 1); PG8_STAGE(PG8_SA(0, 0), a2, voffA);
            PG8_BAR; PG8_WAIT_L(0); PG8_MMA(1, 0, At, B0); PG8_BAR; PG8_SCHED;
            PG8_STAGE(PG8_SB(0, 1), b2 + hstep, voffB);
            PG8_WAIT_V(6); PG8_BAR; PG8_MMA(1, 1, At, B1); PG8_BAR;
            PG8_LDB(B0, 1, 0); PG8_SCHED; PG8_LDA(At, 1, 0); PG8_STAGE(PG8_SA(0, 1), a2 + hstep, voffA);
            PG8_WAIT_L(8); PG8_BAR; PG8_WAIT_L(0); PG8_MMA(0, 0, At, B0); PG8_BAR; PG8_SCHED;
            PG8_LDB(B1, 1, 1); PG8_STAGE(PG8_SB(1, 0), b3, voffB);
            PG8_BAR; PG8_WAIT_L(0); PG8_MMA(0, 1, At, B1); PG8_BAR;
            PG8_LDA(At, 1, 1); PG8_STAGE(PG8_SA(1, 0), a3, voffA);
            PG8_BAR; PG8_WAIT_L(0); PG8_MMA(1, 0, At, B0); PG8_BAR; PG8_SCHED;
            PG8_STAGE(PG8_SB(1, 1), b3 + hstep, voffB);
            PG8_WAIT_V(6); PG8_BAR; PG8_MMA(1, 1, At, B1); PG8_BAR;
            }
        }
        if constexpr (ALIGN_EPI) { if (wr == 0) PG8_BAR; }
        if constexpr (!Epi::AFTER_DRAIN) { E(acc, cur, wr, wc, fr, fq); S.done(cur); }
        if (!has_next) break;
#pragma unroll
        for (int a = 0; a < 2; ++a)
#pragma unroll
            for (int b = 0; b < 2; ++b)
#pragma unroll
                for (int m = 0; m < 4; ++m)
#pragma unroll
                    for (int n = 0; n < 2; ++n) acc[a][b][m][n] = (f32x4){0.f, 0.f, 0.f, 0.f};
        cur = nxt; cA = nA; cB = nB; ++ui;
        if constexpr (ALIGN_EPI) { if (wr == 1) PG8_BAR; }
    }
    PG8_WAIT_V(0);
    if constexpr (!ALIGN_EPI) { if (wr == 0) PG8_BAR; }
    PG8_BAR;
    if constexpr (Epi::AFTER_DRAIN) { E.fused(acc, cur, wr, wc, fr, fq, lds, wid, lane); S.done(cur); }
#undef PG8_SA
#undef PG8_SB
#undef PG8_STAGE
#undef PG8_LDA
#undef PG8_LDB
#undef PG8_MMA
#undef PG8_WAIT_V
#undef PG8_WAIT_L
#undef PG8_BAR
#undef PG8_SCHED
}
}

namespace pg8 {
typedef unsigned u32x2 __attribute__((ext_vector_type(2)));
__device__ __forceinline__ float sigm(float x) { return __builtin_amdgcn_rcpf(1.0f + __builtin_amdgcn_exp2f(-1.4426950409f * x)); }
__device__ __forceinline__ float silu_f(float x) { return x * sigm(x); }
__device__ __forceinline__ float gelu_tanh_f(float x) { return x * sigm(1.5957691216f * (x + 0.044715f * x * x * x)); }
__device__ __forceinline__ float bf2f(unsigned short b) { return __uint_as_float(((unsigned)b) << 16); }

template <bool SCALED> struct EpiSwiGLU {
    static constexpr bool PERM = true, AFTER_DRAIN = false;
    bf16_t* O; int ldc; const PG8_LAS float* rs;
    __device__ __forceinline__ void operator()(const f32x4 (&acc)[2][2][4][2], const Unit& u, int wr, int wc, int fr, int fq) const {
        const int row0 = u.pm * BM + wr * 64 + fr, col0 = u.pn * HALF + wc * 32 + 8 * fq;
#pragma unroll
        for (int ai = 0; ai < 2; ++ai)
#pragma unroll
            for (int m = 0; m < 4; ++m) {
                bf16_t* rowp = O + (size_t)(row0 + ai * HALF + m * 16) * ldc + col0;
                f32x4 g0 = acc[ai][0][m][0], g1 = acc[ai][0][m][1], u0 = acc[ai][1][m][0], u1 = acc[ai][1][m][1];
                if (SCALED) { const float r = rs[ai * HALF + wr * 64 + m * 16 + fr]; g0 = g0 * r; g1 = g1 * r; u0 = u0 * r; u1 = u1 * r; }
                u32x4 w;
                w.x = cvt_pk_bf16(silu_f(g0[0]) * u0[0], silu_f(g0[1]) * u0[1]); w.y = cvt_pk_bf16(silu_f(g0[2]) * u0[2], silu_f(g0[3]) * u0[3]);
                w.z = cvt_pk_bf16(silu_f(g1[0]) * u1[0], silu_f(g1[1]) * u1[1]); w.w = cvt_pk_bf16(silu_f(g1[2]) * u1[2], silu_f(g1[3]) * u1[3]);
                *(u32x4*)rowp = w;
            }
    }
};
template <bool NORM> struct EpiResid {
    static constexpr bool PERM = false, AFTER_DRAIN = false;
    const float* base; float* out; int ldc; float scale; bf16_t* xb; float* ssq;
    __device__ __forceinline__ void operator()(const f32x4 (&acc)[2][2][4][2], const Unit& u, int wr, int wc, int fr, int fq) const {
        int row0 = u.pm * BM + wr * 64 + fr, col0 = u.pn * BM + wc * 32 + 4 * fq;
        asm volatile("" : "+v"(row0), "+v"(col0));
        f32x4 b[2][2][2][2];
#pragma unroll
        for (int ch = 0; ch <= 4; ++ch) {
            if (ch < 4) {
#pragma unroll
                for (int mm = 0; mm < 2; ++mm) { const size_t off = (size_t)(row0 + (ch >> 1) * HALF + ((ch & 1) * 2 + mm) * 16) * ldc + col0;
#pragma unroll
                    for (int bj = 0; bj < 2; ++bj)
#pragma unroll
                        for (int n = 0; n < 2; ++n) b[ch & 1][mm][bj][n] = *(const f32x4*)(base + off + bj * HALF + n * 16); }
            }
            asm volatile("" ::: "memory");
            if (ch > 0) {
                const int pc = ch - 1, ai = pc >> 1;
#pragma unroll
                for (int mm = 0; mm < 2; ++mm) { const int m = (pc & 1) * 2 + mm, row = row0 + ai * HALF + m * 16; const size_t off = (size_t)row * ldc + col0;
                    float s = 0.f;
#pragma unroll
                    for (int bj = 0; bj < 2; ++bj)
#pragma unroll
                        for (int n = 0; n < 2; ++n) {
                            const f32x4 o = b[pc & 1][mm][bj][n] + acc[ai][bj][m][n] * scale;
                            *(f32x4*)(out + off + bj * HALF + n * 16) = o;
                            if (NORM) { s += (o[0] * o[0] + o[1] * o[1]) + (o[2] * o[2] + o[3] * o[3]);
                                u32x2 w; w.x = cvt_pk_bf16(o[0], o[1]); w.y = cvt_pk_bf16(o[2], o[3]); *(u32x2*)(xb + off + bj * HALF + n * 16) = w; }
                        }
                    if (NORM) { s += __shfl_xor(s, 16); s += __shfl_xor(s, 32); ssq[(size_t)row * 32 + u.pn * 4 + wc] = s; }
                }
            }
            asm volatile("" ::: "memory");
        }
    }
};
struct EpiMix {
    static constexpr bool PERM = true, AFTER_DRAIN = false;
    bf16_t *Q, *K, *V, *U, *Z, *G; const float* gbias; float* stats; const PG8_LAS float* rs;
    template <int MODE> __device__ __forceinline__ void body(const f32x4 (&acc)[2][2][4][2], bf16_t* base, int ld, int row0, int cin, int rl0, int fq, const float* bp, float* sbase) const {
        f32x4 bv[2][2];
#pragma unroll
        for (int bj = 0; bj < 2; ++bj)
#pragma unroll
            for (int n = 0; n < 2; ++n) bv[bj][n] = (MODE == 3) ? *(const f32x4*)(bp + bj * HALF + 4 * n) : (f32x4){0.f, 0.f, 0.f, 0.f};
        float S1[2][4], S2[2][4];
#pragma unroll
        for (int ai = 0; ai < 2; ++ai)
#pragma unroll
            for (int m = 0; m < 4; ++m) {
                bf16_t* rowp = base + (size_t)(row0 + ai * HALF + m * 16) * ld + cin;
                const float rsv = rs[ai * HALF + rl0 + m * 16];
                float s1 = 0.f, s2 = 0.f;
#pragma unroll
                for (int bj = 0; bj < 2; ++bj) {
                    f32x4 v0 = acc[ai][bj][m][0] * rsv + bv[bj][0], v1 = acc[ai][bj][m][1] * rsv + bv[bj][1];
                    if (MODE == 1 || MODE == 2) {
#pragma unroll
                        for (int e = 0; e < 4; ++e) { v0[e] = gelu_tanh_f(v0[e]); v1[e] = gelu_tanh_f(v1[e]); }
                    } else if (MODE == 3) {
#pragma unroll
                        for (int e = 0; e < 4; ++e) { v0[e] = sigm(v0[e]); v1[e] = sigm(v1[e]); }
                    }
                    if (MODE == 2) {
#pragma unroll
                        for (int e = 0; e < 4; ++e) { s1 += v0[e] + v1[e]; s2 += v0[e] * v0[e] + v1[e] * v1[e]; }
                    }
                    u32x4 w; w.x = cvt_pk_bf16(v0[0], v0[1]); w.y = cvt_pk_bf16(v0[2], v0[3]); w.z = cvt_pk_bf16(v1[0], v1[1]); w.w = cvt_pk_bf16(v1[2], v1[3]);
                    *(u32x4*)(rowp + bj * HALF) = w;
                }
                if (MODE == 2) { s1 += __shfl_xor(s1, 16); s1 += __shfl_xor(s1, 32); s2 += __shfl_xor(s2, 16); s2 += __shfl_xor(s2, 32); S1[ai][m] = s1; S2[ai][m] = s2; }
            }
        if (MODE == 2) {
            if (fq == 0) {
#pragma unroll
                for (int ai = 0; ai < 2; ++ai)
#pragma unroll
                    for (int m = 0; m < 4; ++m) { float* sp = sbase + (size_t)(row0 + ai * HALF + m * 16) * 32; sp[0] = S1[ai][m]; sp[1] = S2[ai][m]; }
            }
        }
    }
    __device__ __forceinline__ void operator()(const f32x4 (&acc)[2][2][4][2], const Unit& u, int wr, int wc, int fr, int fq) const {
        const int pn = u.pn; int row0 = u.pm * BM + wr * 64 + fr, cin = wc * 32 + 8 * fq, rl0 = wr * 64 + fr;
        asm volatile("" : "+v"(row0), "+v"(cin), "+v"(rl0));
        if (pn < 4) body<0>(acc, Q + pn * BM, 1024, row0, cin, rl0, fq, nullptr, nullptr);
        else if (pn < 6) body<0>(acc, pn == 4 ? K : V, 256, row0, cin, rl0, fq, nullptr, nullptr);
        else if (pn < 10) body<1>(acc, U + (pn - 6) * BM, 1024, row0, cin, rl0, fq, nullptr, nullptr);
        else if (pn < 14) body<2>(acc, Z + (pn - 10) * BM, 1024, row0, cin, rl0, fq, nullptr, stats + ((pn - 10) * 4 + wc) * 2);
        else body<3>(acc, G + (pn - 14) * BM, 4096, row0, cin, rl0, fq, gbias + (pn - 14) * BM + cin, nullptr);
    }
};
template <bool SECOND> struct EpiGate {
    static constexpr bool PERM = true, AFTER_DRAIN = false;
    const bf16_t* G; bf16_t* T;
    __device__ __forceinline__ void operator()(const f32x4 (&acc)[2][2][4][2], const Unit& u, int wr, int wc, int fr, int fq) const {
        int row0 = u.pm * BM + wr * 64 + fr, col0 = u.pn * BM + wc * 32 + 8 * fq;
        asm volatile("" : "+v"(row0), "+v"(col0));
        u32x4 gw[2][2][2], tw[2][2][2];
#pragma unroll
        for (int ch = 0; ch <= 4; ++ch) {
            if (ch < 4) {
#pragma unroll
                for (int mm = 0; mm < 2; ++mm) { const size_t row = (size_t)(row0 + (ch >> 1) * HALF + ((ch & 1) * 2 + mm) * 16);
#pragma unroll
                    for (int bj = 0; bj < 2; ++bj) { const int c = col0 + bj * HALF;
                        gw[ch & 1][mm][bj] = *(const u32x4*)(G + row * 4096 + (SECOND ? 2048 : 0) + c);
                        if (SECOND) tw[ch & 1][mm][bj] = *(const u32x4*)(T + row * 2048 + c); } }
            }
            asm volatile("" ::: "memory");
            if (ch > 0) {
                const int pc = ch - 1, ai = pc >> 1;
#pragma unroll
                for (int mm = 0; mm < 2; ++mm) { const int m = (pc & 1) * 2 + mm; const size_t row = (size_t)(row0 + ai * HALF + m * 16);
#pragma unroll
                    for (int bj = 0; bj < 2; ++bj) { const int c = col0 + bj * HALF;
                        const f32x4 a0 = acc[ai][bj][m][0], a1 = acc[ai][bj][m][1];
                        float o[8];
#pragma unroll
                        for (int e = 0; e < 4; ++e) {
                            const unsigned gwe = gw[pc & 1][mm][bj][e], twe = SECOND ? tw[pc & 1][mm][bj][e] : 0u;
                            const float glo = __uint_as_float(gwe << 16), ghi = __uint_as_float(gwe & 0xffff0000u);
                            const float tlo = __uint_as_float(twe << 16), thi = __uint_as_float(twe & 0xffff0000u);
                            const float alo = (e < 2) ? a0[2 * e] : a1[2 * e - 4], ahi = (e < 2) ? a0[2 * e + 1] : a1[2 * e - 3];
                            o[2 * e] = tlo + glo * alo; o[2 * e + 1] = thi + ghi * ahi;
                        }
                        u32x4 w; w.x = cvt_pk_bf16(o[0], o[1]); w.y = cvt_pk_bf16(o[2], o[3]); w.z = cvt_pk_bf16(o[4], o[5]); w.w = cvt_pk_bf16(o[6], o[7]);
                        *(u32x4*)(T + row * 2048 + c) = w;
                    } }
            }
            asm volatile("" ::: "memory");
        }
    }
};
}

namespace cg = cooperative_groups;
#define LAS __attribute__((address_space(3)))
typedef unsigned short bf16;
typedef float f32x4 __attribute__((ext_vector_type(4)));
typedef unsigned v4u __attribute__((ext_vector_type(4)));
typedef unsigned v2u __attribute__((ext_vector_type(2)));
typedef short bf16x8 __attribute__((ext_vector_type(8)));
typedef short s16x4 __attribute__((ext_vector_type(4)));

constexpr int NWAVES = 8;
constexpr int BATCH = 8, SEQ = 2048, D = 2048, FF = 5632, M = BATCH * SEQ;
constexpr int AW = 1024, KVW = 256, SW = 1024, NMIX = 3584 + 4096;
constexpr float EPS = 1e-6f;
constexpr size_t MiB = 1u << 20;
constexpr size_t WS_STATS = 0, WS_WSM = 2 * MiB, WS_WGU1 = 3 * MiB, WS_WD1 = 47 * MiB, WS_WGU2 = 69 * MiB, WS_WD2 = 113 * MiB, WS_WMIX = 135 * MiB,
                 WS_PA = 165 * MiB, WS_PB = 169 * MiB, WS_WOUT = 173 * MiB, WS_H = 181 * MiB, WS_ACT = 245 * MiB,
                 WS_Q = 245 * MiB, WS_K = 277 * MiB, WS_V = 285 * MiB, WS_U = 293 * MiB, WS_Z = 325 * MiB, WS_G = 357 * MiB, WS_SSQ = 485 * MiB, WS_END = 487 * MiB,
                 WS_T = WS_WGU1;
static_assert(WS_WGU1 + (size_t)2 * FF * D * 2 == WS_WD1 && WS_WD1 + (size_t)D * FF * 2 == WS_WGU2 && WS_WMIX + (size_t)NMIX * D * 2 == WS_PA && WS_H + (size_t)M * D * 2 == WS_ACT &&
              WS_ACT + (size_t)M * FF * 2 <= WS_END && WS_G + (size_t)M * 4096 * 2 == WS_SSQ && WS_T + (size_t)M * D * 2 <= WS_WGU2, "d_ws map");
constexpr size_t WS_BAR = 2 * MiB + 768 * 1024, BAR_BYTES = 16384;
constexpr int MISC_OFF = 131072 + 1024, RS_OFF = 131072 + 2048;
constexpr int LDS_BYTES = 147456;

enum { I_X = 0, I_N1, I_WG1, I_WU1, I_WD1, I_NMIX, I_WIN, I_SINK, I_LNG, I_LNB, I_WS, I_BS, I_PA, I_PB, I_WGATE, I_BGATE, I_WOUT, I_N2, I_WG2, I_WU2, I_WD2, I_NF, N_IN };

struct Args { const float* in[N_IN]; float* out; unsigned char* ws; int ph_lo, ph_hi; };

__device__ __forceinline__ unsigned f2bf(float f) { unsigned u = __builtin_bit_cast(unsigned, f); return (u + 0x7fffu + ((u >> 16) & 1u)) >> 16; }
__device__ __forceinline__ unsigned pk2(float lo, float hi) { typedef float f2_t __attribute__((ext_vector_type(2))); typedef __bf16 b2_t __attribute__((ext_vector_type(2))); const f2_t v = {lo, hi}; return __builtin_bit_cast(unsigned, __builtin_convertvector(v, b2_t)); }
__device__ __forceinline__ float wave_sum(float v) {
#pragma unroll
    for (int o = 1; o < 64; o <<= 1) v += __shfl_xor(v, o);
    return v;
}
#define LDS_WAIT() asm volatile("s_waitcnt lgkmcnt(0)" ::: "memory")

#define XB_TMO      128
#define XB_XCNT(j)  (256  + 64 * (j))
#define XB_XSUB(j)  (1280 + 64 * (j))
#define XB_XGEN(j)  (2304 + 64 * (j))
#define XB_TOP      3328
#define XB_TOPGEN   3392
#define XCD_BAR_WORDS 3456
#define XB_SPIN_CAP (1u << 18)

__device__ __forceinline__ unsigned xb_ld(unsigned* p)              { return __hip_atomic_load(p, __ATOMIC_RELAXED, __HIP_MEMORY_SCOPE_AGENT); }
__device__ __forceinline__ unsigned xb_add(unsigned* p, unsigned v) { return __hip_atomic_fetch_add(p, v, __ATOMIC_RELAXED, __HIP_MEMORY_SCOPE_AGENT); }
__device__ __forceinline__ unsigned xb_xcc_id() { return (unsigned)__builtin_amdgcn_s_getreg((3 << 11) | 20) & 0xFu; }
#define XB_SPIN(cond, bar) do { unsigned _sp = 0; while (cond) { __builtin_amdgcn_s_sleep(1); \
    if ((++_sp & 255u) == 0u) { if (xb_ld(&(bar)[XB_TMO])) break; if (_sp > XB_SPIN_CAP) { atomicAdd(&(bar)[XB_TMO], 1u); break; } } } } while (0)

struct XcdBarrier {
    unsigned* bar; unsigned x;
    volatile LAS unsigned* st;
};

__device__ __forceinline__ XcdBarrier xcd_barrier_post(unsigned* bar, volatile LAS unsigned* st) {
    XcdBarrier b; b.bar = bar; b.x = xb_xcc_id(); b.st = st;
    if (threadIdx.x == 0) (void)xb_add(&bar[XB_XCNT(b.x)], 1u);
    return b;
}
__device__ __forceinline__ void xcd_barrier_complete(unsigned* bar, unsigned x, unsigned& nloc, unsigned& nx) {
    const unsigned G = gridDim.x * gridDim.y * gridDim.z;
    unsigned sum, cnt, mine, sp = 0u;
    for (;;) {
        sum = 0u; cnt = 0u; mine = 0u;
#pragma unroll
        for (unsigned j = 0; j < 16; ++j) { const unsigned c = xb_ld(&bar[XB_XCNT(j)]); sum += c; cnt += (c > 0u) ? 1u : 0u; mine = (j == x) ? c : mine; }
        if (sum == G) break;
        __builtin_amdgcn_s_sleep(1);
        if ((++sp & 255u) == 0u) { if (xb_ld(&bar[XB_TMO])) break; if (sp > XB_SPIN_CAP) { atomicAdd(&bar[XB_TMO], 1u); break; } }
    }
    nloc = mine > 0u ? mine : 1u; nx = cnt > 0u ? cnt : 1u;
}

__device__ __forceinline__ void xcd_barrier(const XcdBarrier& b) {
    asm volatile("s_waitcnt vmcnt(0)" ::: "memory");
    __syncthreads();
    if (threadIdx.x == 0) {
        unsigned* bar = b.bar;
        __builtin_amdgcn_s_waitcnt(0);
        unsigned nloc = b.st[0], nx = b.st[1];
        if (nloc == 0u) { xcd_barrier_complete(bar, b.x, nloc, nx); b.st[0] = nloc; b.st[1] = nx; }
        const unsigned old = xb_add(&bar[XB_XSUB(b.x)], 1u);
        const unsigned gen = old / nloc;
        if (old + 1u == (gen + 1u) * nloc) {
            __builtin_amdgcn_fence(__ATOMIC_RELEASE, "agent");
            asm volatile("s_waitcnt vmcnt(0)" ::: "memory");
            const unsigned og = xb_add(&bar[XB_TOP], 1u);
            const unsigned tg = og / nx;
            if (og + 1u == (tg + 1u) * nx) xb_add(&bar[XB_TOPGEN], 1u);
            else XB_SPIN(xb_ld(&bar[XB_TOPGEN]) == tg, bar);
            __builtin_amdgcn_fence(__ATOMIC_ACQUIRE, "agent");
            xb_add(&bar[XB_XGEN(b.x)], 1u);
            asm volatile("s_waitcnt vmcnt(0)" ::: "memory");
        } else {
            XB_SPIN(xb_ld(&bar[XB_XGEN(b.x)]) == gen, bar);
            __builtin_amdgcn_fence(__ATOMIC_ACQUIRE, "agent");
            asm volatile("s_waitcnt vmcnt(0)" ::: "memory");
        }
    }
    __syncthreads();
}

__device__ __forceinline__ void transpose_item(const float* W, int K, int N, bf16* WT, int mode, int row_off, const float* gain, int item, int lane) {
    const int nblk = N / 64, kb = item / nblk, nb = item % nblk, k0 = 64 * kb, n0 = 64 * nb;
    const int rbase = (mode == 0) ? (row_off + n0) : ((n0 >> 7) * 256 + (n0 & 127) + row_off);
    const float* src = W + (size_t)k0 * N + n0 + lane;
    float v[64];
#pragma unroll
    for (int i = 0; i < 64; ++i) v[i] = src[(size_t)i * N];
    if (gain) {
#pragma unroll
        for (int i = 0; i < 64; ++i) v[i] *= gain[k0 + i];
    }
    bf16* dst = WT + (size_t)(rbase + lane) * K + k0;
#pragma unroll
    for (int c = 0; c < 8; ++c) { v4u o; o.x = pk2(v[8 * c], v[8 * c + 1]); o.y = pk2(v[8 * c + 2], v[8 * c + 3]); o.z = pk2(v[8 * c + 4], v[8 * c + 5]); o.w = pk2(v[8 * c + 6], v[8 * c + 7]);
        *(v4u*)(dst + 8 * c) = o; }
}
template <bool OUT_BF16> __device__ __forceinline__ void rms_rows(const float* X, const float* gain, void* out, int gw, int ngw, int lane) {
    int m = gw;
    for (; m + ngw < M; m += 2 * ngw) {
        const f32x4* xr0 = (const f32x4*)(X + (size_t)m * D) + lane; const f32x4* xr1 = (const f32x4*)(X + (size_t)(m + ngw) * D) + lane;
        f32x4 v0[8], v1[8]; float s0 = 0.f, s1 = 0.f;
#pragma unroll
        for (int j = 0; j < 8; ++j) { v0[j] = xr0[64 * j]; v1[j] = xr1[64 * j]; }
#pragma unroll
        for (int j = 0; j < 8; ++j) { s0 += (v0[j].x * v0[j].x + v0[j].y * v0[j].y) + (v0[j].z * v0[j].z + v0[j].w * v0[j].w); s1 += (v1[j].x * v1[j].x + v1[j].y * v1[j].y) + (v1[j].z * v1[j].z + v1[j].w * v1[j].w); }
        const float rs0 = 1.0f / sqrtf(wave_sum(s0) * (1.0f / D) + EPS), rs1 = 1.0f / sqrtf(wave_sum(s1) * (1.0f / D) + EPS);
#pragma unroll
        for (int j = 0; j < 8; ++j) {
            const f32x4 g = ((const f32x4*)gain)[lane + 64 * j]; const f32x4 o0 = v0[j] * rs0 * g, o1 = v1[j] * rs1 * g;
            if (OUT_BF16) { v2u w0, w1; w0.x = pk2(o0.x, o0.y); w0.y = pk2(o0.z, o0.w); w1.x = pk2(o1.x, o1.y); w1.y = pk2(o1.z, o1.w);
                ((v2u*)((bf16*)out + (size_t)m * D))[lane + 64 * j] = w0; ((v2u*)((bf16*)out + (size_t)(m + ngw) * D))[lane + 64 * j] = w1; }
            else { ((f32x4*)((float*)out + (size_t)m * D))[lane + 64 * j] = o0; ((f32x4*)((float*)out + (size_t)(m + ngw) * D))[lane + 64 * j] = o1; }
        }
    }
    for (; m < M; m += ngw) {
        const f32x4* xr = (const f32x4*)(X + (size_t)m * D) + lane;
        f32x4 v[8]; float s = 0.f;
#pragma unroll
        for (int j = 0; j < 8; ++j) { v[j] = xr[64 * j]; s += (v[j].x * v[j].x + v[j].y * v[j].y) + (v[j].z * v[j].z + v[j].w * v[j].w); }
        const float rs = 1.0f / sqrtf(wave_sum(s) * (1.0f / D) + EPS);
#pragma unroll
        for (int j = 0; j < 8; ++j) {
            const f32x4 g = ((const f32x4*)gain)[lane + 64 * j]; const f32x4 o = v[j] * rs * g;
            if (OUT_BF16) { v2u w; w.x = pk2(o.x, o.y); w.y = pk2(o.z, o.w); ((v2u*)((bf16*)out + (size_t)m * D))[lane + 64 * j] = w; }
            else ((f32x4*)((float*)out + (size_t)m * D))[lane + 64 * j] = o;
        }
    }
}

constexpr int KS_LD = 72, VT_LD = 264, KS_BYTES = 256 * KS_LD * 2;
template <bool FULL> __device__ __forceinline__ void attn_qtile(const LAS bf16* Ks, const LAS bf16* Vt, const bf16* QO, bf16* Oout, int row_cur, int h, int qt, int fr, int fq, float slope8, float sink8) {
    const int qi = qt * 16 + fr, kt0 = qt < 6 ? qt : 6;
    const bf16* qrow = QO + (size_t)(row_cur + qi) * AW + h * 64; bf16* orow = Oout + (size_t)(row_cur + qi) * AW + h * 64;
    bf16x8 qf[2]; qf[0] = *(const bf16x8*)(qrow + fq * 8); qf[1] = *(const bf16x8*)(qrow + 32 + fq * 8);
    const int d0 = 128 + qi - kt0 * 16 - fq * 4;
    const int e0 = 128 - kt0 * 16 - fq * 4;
    const float a0 = -slope8 * (float)d0;
    f32x4 S[10];
#pragma unroll
    for (int j = 0; j < 10; ++j) {
#pragma unroll
        for (int i = 0; i < 4; ++i) S[j][i] = fmaf(slope8, (float)(16 * j + i), a0);
#pragma unroll
        for (int ks = 0; ks < 2; ++ks) {
            const bf16x8 kf = *(const LAS bf16x8*)(Ks + ((kt0 + j) * 16 + fr) * KS_LD + ks * 32 + fq * 8);
            S[j] = __builtin_amdgcn_mfma_f32_16x16x32_bf16(kf, qf[ks], S[j], 0, 0, 0);
        }
    }
    float mx = sink8;
#pragma unroll
    for (int j = 0; j < 10; ++j)
#pragma unroll
        for (int i = 0; i < 4; ++i) {
            if (FULL || j < 2 || j > 7) {
                const int c = 16 * j + i; bool ok = (unsigned)(d0 - c) < 128u; if (FULL) ok = ok && (c >= e0);
                S[j][i] = ok ? S[j][i] : -1e30f;
            }
            mx = fmaxf(mx, S[j][i]);
        }
    mx = fmaxf(mx, __shfl_xor(mx, 16)); mx = fmaxf(mx, __shfl_xor(mx, 32));
    const float C = 0.125f * 1.4426950409f, nm = -mx * C;
    float sum = 0.f;
#pragma unroll
    for (int j = 0; j < 10; ++j)
#pragma unroll
        for (int i = 0; i < 4; ++i) { const float p = __builtin_amdgcn_exp2f(fmaf(S[j][i], C, nm)); S[j][i] = p; sum += p; }
    sum += __shfl_xor(sum, 16); sum += __shfl_xor(sum, 32);
    sum += __builtin_amdgcn_exp2f(fmaf(sink8, C, nm));
    const float inv = 1.0f / sum;
    f32x4 O[4];
#pragma unroll
    for (int dt = 0; dt < 4; ++dt) O[dt] = (f32x4){0.f, 0.f, 0.f, 0.f};
#pragma unroll
    for (int kk = 0; kk < 5; ++kk) {
        v4u pw; pw.x = pk2(S[2 * kk][0], S[2 * kk][1]); pw.y = pk2(S[2 * kk][2], S[2 * kk][3]); pw.z = pk2(S[2 * kk + 1][0], S[2 * kk + 1][1]); pw.w = pk2(S[2 * kk + 1][2], S[2 * kk + 1][3]);
        const bf16x8 pb = __builtin_bit_cast(bf16x8, pw);
#pragma unroll
        for (int dt = 0; dt < 4; ++dt) {
            const LAS bf16* vp = Vt + (dt * 16 + fr) * VT_LD + (kt0 + 2 * kk) * 16 + fq * 4;
            const v2u a0v = *(const LAS v2u*)vp, a1v = *(const LAS v2u*)(vp + 16);
            v4u aw; aw.x = a0v.x; aw.y = a0v.y; aw.z = a1v.x; aw.w = a1v.y;
            O[dt] = __builtin_amdgcn_mfma_f32_16x16x32_bf16(__builtin_bit_cast(bf16x8, aw), pb, O[dt], 0, 0, 0);
        }
    }
#pragma unroll
    for (int dt = 0; dt < 4; ++dt) { v2u w; w.x = pk2(O[dt][0] * inv, O[dt][1] * inv); w.y = pk2(O[dt][2] * inv, O[dt][3] * inv); *(v2u*)(orow + dt * 16 + fq * 4) = w; }
}

__device__ __forceinline__ void attn_unit(LAS unsigned char* lds, const bf16* QO, bf16* Oout, const bf16* Kb, const bf16* Vb, const float* sinks, int unit, int tid, int wave, int lane) {
    const int b = unit >> 6, blk = (unit >> 2) & 15, kvh = unit & 3;
    const int row_cur = b * SEQ + blk * 128;
    LAS bf16* Ks = (LAS bf16*)lds; LAS bf16* Vt = (LAS bf16*)(lds + KS_BYTES);
    __syncthreads();
#pragma unroll
    for (int i = 0; i < 4; ++i) {
        const int idx = tid + i * 512, key = idx >> 3, ch = idx & 7; const bool ok = (blk > 0) || (key >= 128);
        v4u v = (v4u){0u, 0u, 0u, 0u}; if (ok) v = *(const v4u*)(Kb + (size_t)(row_cur - 128 + key) * KVW + kvh * 64 + ch * 8);
        *(LAS v4u*)(Ks + key * KS_LD + ch * 8) = v;
    }
#pragma unroll
    for (int i = 0; i < 4; ++i) {
        const int idx = tid + i * 512, key = idx & 255, ch = idx >> 8; const bool ok = (blk > 0) || (key >= 128);
        v4u v = (v4u){0u, 0u, 0u, 0u}; if (ok) v = *(const v4u*)(Vb + (size_t)(row_cur - 128 + key) * KVW + kvh * 64 + ch * 8);
#pragma unroll
        for (int e = 0; e < 4; ++e) { Vt[(ch * 8 + 2 * e) * VT_LD + key] = (bf16)(v[e] & 0xffffu); Vt[(ch * 8 + 2 * e + 1) * VT_LD + key] = (bf16)(v[e] >> 16); }
    }
    __syncthreads();
    const int h = kvh * 4 + (wave >> 1), fr = lane & 15, fq = lane >> 4;
    const float slope8 = 8.0f * __builtin_amdgcn_exp2f(-0.5f * (float)(h + 1)), sink8 = 8.0f * sinks[h];
    if (blk == 0) { for (int qq = 0; qq < 4; ++qq) attn_qtile<true>(Ks, Vt, QO, Oout, row_cur, h, (wave & 1) * 4 + qq, fr, fq, slope8, sink8); }
    else          { for (int qq = 0; qq < 4; ++qq) attn_qtile<false>(Ks, Vt, QO, Oout, row_cur, h, (wave & 1) * 4 + qq, fr, fq, slope8, sink8); }
}

constexpr int ZT_LD = 136, ZT_BYTES = 256 * ZT_LD * 2;
__device__ __forceinline__ void sgu_unit(LAS unsigned char* lds, const bf16* U, bf16* Uout, const bf16* Zb, const float* stats, const float* lng, const float* lnb, const bf16* wsm, const float* bs,
                                         int unit, int tid, int wave, int lane) {
    const int b = unit >> 6, chunk = (unit >> 2) & 15, gq = unit & 3;
    const int row0 = b * SEQ + chunk * 128, colbase = gq * 256;
    LAS bf16* zt = (LAS bf16*)lds; LAS float* st = (LAS float*)(lds + ZT_BYTES);
    __syncthreads();
    if (tid < 128) {
        const f32x4* sp = (const f32x4*)(stats + (size_t)(row0 + tid) * 32); float s1 = 0.f, s2 = 0.f;
#pragma unroll
        for (int p = 0; p < 8; ++p) { const f32x4 v = sp[p]; s1 += v.x + v.z; s2 += v.y + v.w; }
        const float mu = s1 * (1.0f / SW), var = fmaxf(s2 * (1.0f / SW) - mu * mu, 0.f);
        st[2 * tid] = mu; st[2 * tid + 1] = 1.0f / sqrtf(var + EPS);
    }
    __syncthreads();
#pragma unroll 2
    for (int i = 0; i < 8; ++i) {
        const int idx = tid + i * 512, s = idx & 127, c8 = idx >> 7;
        const v4u z = *(const v4u*)(Zb + (size_t)(row0 + s) * SW + colbase + c8 * 8);
        const float mu = st[2 * s], rstd = st[2 * s + 1];
        const float* gp = lng + colbase + c8 * 8; const float* bp = lnb + colbase + c8 * 8;
#pragma unroll
        for (int e = 0; e < 4; ++e) {
            const float zlo = __uint_as_float(z[e] << 16), zhi = __uint_as_float(z[e] & 0xffff0000u);
            const unsigned zp = pk2((zlo - mu) * rstd * gp[2 * e] + bp[2 * e], (zhi - mu) * rstd * gp[2 * e + 1] + bp[2 * e + 1]);
            zt[(c8 * 8 + 2 * e) * ZT_LD + s] = (bf16)(zp & 0xffffu);
            zt[(c8 * 8 + 2 * e + 1) * ZT_LD + s] = (bf16)(zp >> 16);
        }
    }
    __syncthreads();
    const int fr = lane & 15, fq = lane >> 4, t = wave * 16 + fr, nks = (wave >> 1) + 1;
    f32x4 acc[16];
#pragma unroll
    for (int ct = 0; ct < 16; ++ct) acc[ct] = (f32x4){0.f, 0.f, 0.f, 0.f};
    for (int ks = 0; ks < nks; ++ks) {
        bf16x8 wb[4];
#pragma unroll
        for (int gi = 0; gi < 4; ++gi) wb[gi] = *(const bf16x8*)(wsm + ((size_t)((gq * 4 + gi) * 128 + t)) * 128 + ks * 32 + fq * 8);
#pragma unroll
        for (int ct = 0; ct < 16; ++ct) {
            const bf16x8 za = *(const LAS bf16x8*)(zt + (ct * 16 + fr) * ZT_LD + ks * 32 + fq * 8);
            acc[ct] = __builtin_amdgcn_mfma_f32_16x16x32_bf16(za, wb[ct >> 2], acc[ct], 0, 0, 0);
        }
    }
    const bf16* urow = U + (size_t)(row0 + t) * SW + colbase + fq * 4; bf16* uorow = Uout + (size_t)(row0 + t) * SW + colbase + fq * 4;
#pragma unroll
    for (int ct = 0; ct < 16; ++ct) {
        const float bias = bs[(gq * 4 + (ct >> 2)) * 128 + t];
        const v2u uw = *(const v2u*)(urow + ct * 16);
        const float u0 = __uint_as_float(uw.x << 16), u1 = __uint_as_float(uw.x & 0xffff0000u), u2 = __uint_as_float(uw.y << 16), u3 = __uint_as_float(uw.y & 0xffff0000u);
        v2u w; w.x = pk2(u0 * (acc[ct][0] + bias), u1 * (acc[ct][1] + bias)); w.y = pk2(u2 * (acc[ct][2] + bias), u3 * (acc[ct][3] + bias));
        *(v2u*)(uorow + ct * 16) = w;
    }
}

__device__ __forceinline__ void panel_scales(LAS unsigned char* lds, const float* ssq, int pm, int tid) {
    const int r = tid >> 1, h = tid & 1;
    const f32x4* p = (const f32x4*)(ssq + (size_t)(pm * 256 + r) * 32 + h * 16);
    const f32x4 a = p[0], b = p[1], c = p[2], d = p[3];
    float sum = (((a.x + a.y) + (a.z + a.w)) + ((b.x + b.y) + (b.z + b.w))) + (((c.x + c.y) + (c.z + c.w)) + ((d.x + d.y) + (d.z + d.w)));
    sum += __shfl_xor(sum, 1);
    if (h == 0) ((LAS float*)(lds + RS_OFF))[r] = 1.0f / sqrtf(sum * (1.0f / D) + EPS);
    __syncthreads();
}

#ifndef MK_N_LAUNCHES
#define MK_N_LAUNCHES 1
#endif
constexpr int N_PHASES = 12;
constexpr int IT_FF = (D / 64) * (FF / 64), IT_DN = (FF / 64) * (D / 64), IT_WIN = (D / 64) * (3584 / 64), IT_WG = (D / 64) * (4096 / 64), IT_P = (AW / 64) * (D / 64), IT_O = (D / 64) * (D / 64);
constexpr int N_EARLY = 2 * IT_FF + IT_DN + IT_WIN + IT_WG, N_LATE = 2 * IT_P + IT_O + 2 * IT_FF + IT_DN;
static_assert(N_LATE % 8 == 0, "late items are dealt over 8 queue heads");

__global__ void __launch_bounds__(NWAVES * 64, 2) hybrid_fwd(Args args) {
    extern __shared__ __attribute__((aligned(16))) unsigned char lds_raw[];
    LAS unsigned char* lds = (LAS unsigned char*)lds_raw;
    const int tid = threadIdx.x, lane = tid & 63, wave = __builtin_amdgcn_readfirstlane(tid >> 6);
    const int G = gridDim.x, gw = blockIdx.x * NWAVES + wave, ngw = G * NWAVES;
    unsigned char* ws = args.ws;
    const int lo = args.ph_lo, hi = args.ph_hi;
#define IN(k) (lo <= (k) && (k) < hi)
    if (tid < 64) ((LAS unsigned*)(lds + MISC_OFF))[tid] = 0u;
    __syncthreads();
    XcdBarrier bar; bar.bar = (unsigned*)(ws + WS_BAR); bar.x = 0; bar.st = (volatile LAS unsigned*)(lds + MISC_OFF + 32);
    if (hi - lo > 1) bar = xcd_barrier_post((unsigned*)(ws + WS_BAR), (volatile LAS unsigned*)(lds + MISC_OFF + 32));
#define SEAM(k) do { if (IN(k) && IN((k) + 1)) xcd_barrier(bar); } while (0)
    if (lo < 0) cg::this_grid().sync();
    bf16* Hb = (bf16*)(ws + WS_H); bf16* ACT = (bf16*)(ws + WS_ACT); bf16* Tb = (bf16*)(ws + WS_T); float* ssq = (float*)(ws + WS_SSQ);
    bf16 *Qb = (bf16*)(ws + WS_Q), *Kb = (bf16*)(ws + WS_K), *Vb = (bf16*)(ws + WS_V), *Ub = (bf16*)(ws + WS_U), *Zb = (bf16*)(ws + WS_Z), *Gb = (bf16*)(ws + WS_G);
    float* stats = (float*)(ws + WS_STATS); bf16* wsm = (bf16*)(ws + WS_WSM);

    if (IN(0)) {
        for (int it = gw; it < N_EARLY; it += ngw) {
            int r = it;
            if (r < IT_FF) { transpose_item(args.in[I_WG1], D, FF, (bf16*)(ws + WS_WGU1), 1, 0, nullptr, r, lane); continue; } r -= IT_FF;
            if (r < IT_FF) { transpose_item(args.in[I_WU1], D, FF, (bf16*)(ws + WS_WGU1), 1, 128, nullptr, r, lane); continue; } r -= IT_FF;
            if (r < IT_DN) { transpose_item(args.in[I_WD1], FF, D, (bf16*)(ws + WS_WD1), 0, 0, nullptr, r, lane); continue; } r -= IT_DN;
            if (r < IT_WIN) { transpose_item(args.in[I_WIN], D, 3584, (bf16*)(ws + WS_WMIX), 0, 0, args.in[I_NMIX], r, lane); continue; } r -= IT_WIN;
            transpose_item(args.in[I_WGATE], D, 4096, (bf16*)(ws + WS_WMIX), 0, 3584, args.in[I_NMIX], r, lane);
        }
        for (int e = blockIdx.x * 512 + tid; e < 16 * 128 * 128; e += G * 512) { const int s = e & 127, t = (e >> 7) & 127; wsm[e] = (s <= t) ? (bf16)f2bf(args.in[I_WS][e]) : (bf16)0; }
        rms_rows<true>(args.in[I_X], args.in[I_N1], Hb, gw, ngw, lane);
    }
    SEAM(0);
    if (IN(1)) {
        pg8::Gemm g{Hb, (const bf16*)(ws + WS_WGU1), M, 2 * FF, D}; pg8::StaticOrder S; S.init(M, 2 * FF, G, (int)blockIdx.x);
        pg8::EpiSwiGLU<false> E{ACT, FF, nullptr};
        pg8::gemm_phase<pg8::EpiSwiGLU<false>, pg8::StaticOrder, true, true>(lds, g, S, E);
    }
    SEAM(1);
    if (IN(2)) {
        pg8::Gemm g{ACT, (const bf16*)(ws + WS_WD1), M, D, FF}; pg8::StaticOrder S; S.init(M, D, G, (int)blockIdx.x);
        pg8::EpiResid<true> E{args.in[I_X], args.out, D, 0.5f, Hb, ssq};
        pg8::gemm_phase<pg8::EpiResid<true>, pg8::StaticOrder, true, true>(lds, g, S, E);
    }
    SEAM(2);
    if (IN(4)) {
        pg8::Gemm g{Hb, (const bf16*)(ws + WS_WMIX), M, NMIX, D}; pg8::StaticOrder S; S.init(M, NMIX, G, (int)blockIdx.x);
        { pg8::Unit u0; if (S.next(0, u0)) panel_scales(lds, ssq, u0.pm, tid); else __syncthreads(); }
        pg8::EpiMix E{Qb, Kb, Vb, Ub, Zb, Gb, args.in[I_BGATE], stats, (const LAS float*)(lds + RS_OFF)};
        pg8::gemm_phase<pg8::EpiMix, pg8::StaticOrder, true, true>(lds, g, S, E);
        unsigned* qheads = (unsigned*)(ws + WS_BAR + 14336);
        const int myq = (int)(xb_xcc_id() & 7u);
        for (int q = 0; q < 8; ++q) {
            const int qi = (myq + q) & 7;
            for (;;) {
                int t = 0;
                if (lane == 0) t = (int)__hip_atomic_fetch_add(qheads + 64 * qi, 1u, __ATOMIC_RELAXED, __HIP_MEMORY_SCOPE_AGENT);
                t = __builtin_amdgcn_readfirstlane(t);
                if (t >= N_LATE / 8) break;
                int r = t * 8 + qi;
                if (r < IT_P) { transpose_item(args.in[I_PA], AW, D, (bf16*)(ws + WS_PA), 0, 0, nullptr, r, lane); continue; } r -= IT_P;
                if (r < IT_P) { transpose_item(args.in[I_PB], SW, D, (bf16*)(ws + WS_PB), 0, 0, nullptr, r, lane); continue; } r -= IT_P;
                if (r < IT_O) { transpose_item(args.in[I_WOUT], D, D, (bf16*)(ws + WS_WOUT), 0, 0, nullptr, r, lane); continue; } r -= IT_O;
                if (r < IT_FF) { transpose_item(args.in[I_WG2], D, FF, (bf16*)(ws + WS_WGU2), 1, 0, args.in[I_N2], r, lane); continue; } r -= IT_FF;
                if (r < IT_FF) { transpose_item(args.in[I_WU2], D, FF, (bf16*)(ws + WS_WGU2), 1, 128, args.in[I_N2], r, lane); continue; } r -= IT_FF;
                transpose_item(args.in[I_WD2], FF, D, (bf16*)(ws + WS_WD2), 0, 0, nullptr, r, lane);
            }
        }
    }
    SEAM(4);
    if (IN(5)) {
        for (int i = blockIdx.x; i < 1024; i += G) {
            if (i < 512) attn_unit(lds, Qb, Qb, Kb, Vb, args.in[I_SINK], i, tid, wave, lane);
            else sgu_unit(lds, Ub, Ub, Zb, stats, args.in[I_LNG], args.in[I_LNB], wsm, args.in[I_BS], i - 512, tid, wave, lane);
        }
        __syncthreads();
    }
    SEAM(5);
    if (IN(6)) {
        { pg8::Gemm g{Qb, (const bf16*)(ws + WS_PA), M, D, AW}; pg8::StaticOrder S; S.init(M, D, G, (int)blockIdx.x);
          pg8::EpiGate<false> E{Gb, Tb}; pg8::gemm_phase<pg8::EpiGate<false>, pg8::StaticOrder, true, true>(lds, g, S, E); }
        { pg8::Gemm g{Ub, (const bf16*)(ws + WS_PB), M, D, SW}; pg8::StaticOrder S; S.init(M, D, G, (int)blockIdx.x);
          pg8::EpiGate<true> E{Gb, Tb}; pg8::gemm_phase<pg8::EpiGate<true>, pg8::StaticOrder, true, true>(lds, g, S, E); }
    }
    SEAM(6);
    if (IN(7)) {
        pg8::Gemm g{Tb, (const bf16*)(ws + WS_WOUT), M, D, D}; pg8::StaticOrder S; S.init(M, D, G, (int)blockIdx.x);
        pg8::EpiResid<true> E{args.out, args.out, D, 1.0f, Hb, ssq};
        pg8::gemm_phase<pg8::EpiResid<true>, pg8::StaticOrder, true, true>(lds, g, S, E);
    }
    SEAM(7);
    if (IN(9)) {
        pg8::Gemm g{Hb, (const bf16*)(ws + WS_WGU2), M, 2 * FF, D}; pg8::StaticOrder S; S.init(M, 2 * FF, G, (int)blockIdx.x);
        { pg8::Unit u0; if (S.next(0, u0)) panel_scales(lds, ssq, u0.pm, tid); else __syncthreads(); }
        pg8::EpiSwiGLU<true> E{ACT, FF, (const LAS float*)(lds + RS_OFF)};
        pg8::gemm_phase<pg8::EpiSwiGLU<true>, pg8::StaticOrder, true, true>(lds, g, S, E);
    }
    SEAM(9);
    if (IN(10)) {
        pg8::Gemm g{ACT, (const bf16*)(ws + WS_WD2), M, D, FF}; pg8::StaticOrder S; S.init(M, D, G, (int)blockIdx.x);
        pg8::EpiResid<false> E{args.out, args.out, D, 0.5f, nullptr, nullptr};
        pg8::gemm_phase<pg8::EpiResid<false>, pg8::StaticOrder, true, true>(lds, g, S, E);
    }
    SEAM(10);
    if (IN(11)) rms_rows<false>(args.out, args.in[I_NF], args.out, gw, ngw, lane);
#undef IN
#undef SEAM
}

extern "C" void kernel_launch(void* const* d_in, const int* in_sizes, int n_in, void* d_out, int out_size, void* d_ws, size_t ws_size, hipStream_t stream) {
    static int grid = 0;
    if (grid == 0) {
        if (n_in != N_IN || in_sizes[0] != M * D || out_size != M * D || ws_size < WS_END) { fprintf(stderr, "kernel_launch: unexpected shapes (n_in %d, in0 %d, out %d, ws %zu)\n", n_in, n_in > 0 ? in_sizes[0] : -1, out_size, ws_size); grid = -1; return; }
        int dev = 0, cus = 0, per_cu = 0;
        if (hipGetDevice(&dev) != hipSuccess || hipDeviceGetAttribute(&cus, hipDeviceAttributeMultiprocessorCount, dev) != hipSuccess) { grid = -1; return; }
        if (hipFuncSetAttribute((const void*)hybrid_fwd, hipFuncAttributeMaxDynamicSharedMemorySize, LDS_BYTES) != hipSuccess) { fprintf(stderr, "kernel_launch: hipFuncSetAttribute failed\n"); grid = -1; return; }
        if (hipOccupancyMaxActiveBlocksPerMultiprocessor(&per_cu, (const void*)hybrid_fwd, NWAVES * 64, LDS_BYTES) != hipSuccess || per_cu < 1) { fprintf(stderr, "kernel_launch: occupancy query says %d\n", per_cu); per_cu = 1; }
        (void)hipGetLastError();
        grid = (cus / 64) * 64;
        if (grid < 64) { fprintf(stderr, "kernel_launch: needs at least 64 CUs\n"); grid = -1; return; }
        (void)per_cu;
    }
    if (grid < 0) return;
    if (hipMemsetAsync((char*)d_ws + WS_BAR, 0, BAR_BYTES, stream) != hipSuccess) { fprintf(stderr, "kernel_launch: memset failed\n"); return; }
    Args a{};
    for (int i = 0; i < N_IN; ++i) a.in[i] = (const float*)d_in[i];
    a.out = (float*)d_out; a.ws = (unsigned char*)d_ws;
#if MK_N_LAUNCHES == 1
    a.ph_lo = 0; a.ph_hi = N_PHASES;
    void* kargs[] = {&a};
    hipError_t e = hipLaunchCooperativeKernel((const void*)hybrid_fwd, dim3(grid), dim3(NWAVES * 64), kargs, LDS_BYTES, stream);
    if (e != hipSuccess) fprintf(stderr, "kernel_launch: cooperative launch failed: %s (grid %d)\n", hipGetErrorString(e), grid);
#else
    for (int p = 0; p < N_PHASES; ++p) {
        a.ph_lo = p; a.ph_hi = p + 1;
        hipLaunchKernelGGL(hybrid_fwd, dim3(grid), dim3(NWAVES * 64), LDS_BYTES, stream, a);
    }
#endif
}
```

```cpp
#include <hip/hip_runtime.h>
#include <hip/hip_cooperative_groups.h>
#include <cstdio>
#include <cstdint>
namespace pg8 {
#define PG8_LAS __attribute__((address_space(3)))
typedef unsigned short bf16_t;
typedef short bf16x8 __attribute__((ext_vector_type(8)));
typedef float f32x4 __attribute__((ext_vector_type(4)));
typedef unsigned u32x4 __attribute__((ext_vector_type(4)));
constexpr int BM = 256, BK = 64, HALF = 128, HTB = HALF * BK * 2  , STAGE_BYTES = 8 * HTB, NXCD = 8, WGM = 8;

__host__ __device__ __forceinline__ int lds_byte(int r, int c) { const int st = (r >> 4) * 2 + (c >> 5), rr = r & 15, cc = c & 31, ob = rr * 64 + cc * 2; return st * 1024 + (ob ^ (((ob >> 9) & 1) << 5)); }
__host__ __device__ __forceinline__ void stage_rc(int b, int& R, int& C) { const int st = b / 1024, sb = b % 1024, swz = sb ^ (((sb >> 9) & 1) << 5); R = (st >> 1) * 16 + swz / 64; C = (st & 1) * 32 + (swz % 64) / 2; }
__host__ __device__ __forceinline__ int perm32(int rho) { const int n = rho >> 4, i = rho & 15; return 8 * (i >> 2) + 4 * n + (i & 3); }

struct Unit { int pm, pn; };
struct Gemm { const bf16_t* A; const bf16_t* Bt; int M, N, K; };

struct StaticOrder {
    int nM, nN, nwg, G, c;
    __host__ __device__ void init(int M, int N, int G_, int c_) { nM = M / BM; nN = N / BM; nwg = nM * nN; G = G_; c = c_; }
    __host__ __device__ bool next(int i, Unit& u) const {
        const long L = (long)i * G + c; if (L >= nwg) return false;
        int wgid = (int)L; { const int q = nwg / NXCD, r = nwg % NXCD, xcd = wgid % NXCD, off = wgid / NXCD; wgid = (xcd < r ? xcd * (q + 1) : r * (q + 1) + (xcd - r) * q) + off; }
        const int nig = WGM * nN, gid = wgid / nig, fm = gid * WGM, gsz = (nM - fm) < WGM ? (nM - fm) : WGM;
        u.pm = fm + ((wgid % nig) % gsz); u.pn = (wgid % nig) / gsz; return true;
    }
    __device__ __forceinline__ void a_ready(const Unit&) const {}
    __device__ __forceinline__ void done(const Unit&) const {}
};

__device__ __forceinline__ unsigned cvt_pk_bf16(float lo, float hi) { typedef float f2_t __attribute__((ext_vector_type(2))); typedef __bf16 b2_t __attribute__((ext_vector_type(2))); const f2_t v = {lo, hi}; return __builtin_bit_cast(unsigned, __builtin_convertvector(v, b2_t)); }
template <class Epi, class Sched, bool ALIGN_EPI = false, bool SP2 = false>
__device__ __forceinline__ void gemm_phase(PG8_LAS unsigned char* lds, const Gemm g, const Sched& S, const Epi& E) {
    const int tid = threadIdx.x, wid = __builtin_amdgcn_readfirstlane(tid >> 6), lane = tid & 63, wr = wid >> 2, wc = wid & 3, fr = lane & 15, fq = lane >> 4;
    const int K = g.K, nt = K / BK;
    unsigned voffA[2], voffB[2];
#pragma unroll
    for (int i = 0; i < 2; ++i) { int R, C; stage_rc(tid * 16 + i * 8192, R, C); const int Rb = Epi::PERM ? ((R & ~31) + perm32(R & 31)) : R;
        voffA[i] = (unsigned)(R * K + C) * 2u; voffB[i] = (unsigned)(Rb * K + C) * 2u; }
    const size_t kstep = (size_t)(BK * 2);
    const size_t hstep = (size_t)HALF * K * 2;
    const size_t tstep = 2 * hstep;
    const unsigned ldsw = (unsigned)wid * 1024u;
    const int aoff = lds_byte(wr * 64 + fr, fq * 8), boff = lds_byte(wc * 32 + fr, fq * 8);
    const __amdgpu_buffer_rsrc_t rsrc_voffA = __builtin_amdgcn_make_buffer_rsrc((void*)g.A, 0, 0x7ffffff0, 0x00020000), rsrc_voffB = __builtin_amdgcn_make_buffer_rsrc((void*)g.Bt, 0, 0x7ffffff0, 0x00020000);
    const char* const base_voffA = (const char*)g.A; const char* const base_voffB = (const char*)g.Bt;
#define PG8_SA(b, h) (((b) * 2 + (h)) * HTB)
#define PG8_SB(b, h) ((4 + (b) * 2 + (h)) * HTB)
#define PG8_STAGE(bufoff, gbase, voff) do { const int _so = (int)((const char*)(gbase) - base_##voff); _Pragma("unroll") for (int _i = 0; _i < 2; ++_i) \
        __builtin_amdgcn_raw_ptr_buffer_load_lds(rsrc_##voff, (PG8_LAS unsigned*)(lds + (bufoff) + ldsw + _i * 8192), 16, (int)(voff)[_i], _so, 0, 0); } while (0)
#define PG8_LDA(dst, b, h) do { _Pragma("unroll") for (int m = 0; m < 4; ++m) _Pragma("unroll") for (int k = 0; k < 2; ++k) dst[m][k] = *(const PG8_LAS bf16x8*)(lds + PG8_SA(b, h) + aoff + m * 2048 + k * 1024); } while (0)
#define PG8_LDB(dst, b, h) do { _Pragma("unroll") for (int n = 0; n < 2; ++n) _Pragma("unroll") for (int k = 0; k < 2; ++k) dst[n][k] = *(const PG8_LAS bf16x8*)(lds + PG8_SB(b, h) + boff + n * 2048 + k * 1024); } while (0)
#define PG8_MMA(ai, bj, At, Bt) do { __builtin_amdgcn_s_setprio(1); _Pragma("unroll") for (int m = 0; m < 4; ++m) _Pragma("unroll") for (int n = 0; n < 2; ++n) _Pragma("unroll") for (int k = 0; k < 2; ++k) \
        acc[ai][bj][m][n] = __builtin_amdgcn_mfma_f32_16x16x32_bf16(Bt[n][k], At[m][k], acc[ai][bj][m][n], 0, 0, 0); __builtin_amdgcn_s_setprio(0); } while (0)
#define PG8_MMA0(ai, bj, At, Bt) do { __builtin_amdgcn_s_setprio(1); _Pragma("unroll") for (int m = 0; m < 4; ++m) _Pragma("unroll") for (int n = 0; n < 2; ++n) { \
        acc[ai][bj][m][n] = __builtin_amdgcn_mfma_f32_16x16x32_bf16(Bt[n][0], At[m][0], (f32x4){0.f, 0.f, 0.f, 0.f}, 0, 0, 0); \
        acc[ai][bj][m][n] = __builtin_amdgcn_mfma_f32_16x16x32_bf16(Bt[n][1], At[m][1], acc[ai][bj][m][n], 0, 0, 0); } __builtin_amdgcn_s_setprio(0); } while (0)
#define PG8_WAIT_V(n) asm volatile("s_waitcnt vmcnt(" #n ")" ::: "memory")
#define PG8_WAIT_L(n) asm volatile("s_waitcnt lgkmcnt(" #n ")" ::: "memory")
#define PG8_BAR __builtin_amdgcn_s_barrier()
#define PG8_SCHED __builtin_amdgcn_sched_barrier(0)
    Unit cur, nxt; int ui = 0;
    if (!S.next(0, cur)) return;
    static_assert(SP2, "this build keeps only the two-super-phase K-loop");
    f32x4 acc[2][2][4][2];
    bf16x8 At[4][2], B0[2][2], B1[2][2];
    const char* cA = (const char*)g.A + (size_t)cur.pm * tstep; const char* cB = (const char*)g.Bt + (size_t)cur.pn * tstep;
    S.a_ready(cur);
    if constexpr (SP2) {
        PG8_STAGE(PG8_SB(0, 0), cB, voffB); PG8_STAGE(PG8_SB(0, 1), cB + hstep, voffB); PG8_STAGE(PG8_SA(0, 0), cA, voffA); PG8_STAGE(PG8_SA(0, 1), cA + hstep, voffA);
        if (wr == 1) PG8_BAR;
        PG8_WAIT_V(2); PG8_BAR;
        PG8_STAGE(PG8_SB(1, 0), cB + kstep, voffB); PG8_STAGE(PG8_SA(1, 0), cA + kstep, voffA); PG8_STAGE(PG8_SB(1, 1), cB + hstep + kstep, voffB);
        PG8_WAIT_V(6); PG8_BAR;
    } else {
        PG8_STAGE(PG8_SB(0, 0), cB, voffB); PG8_STAGE(PG8_SA(0, 0), cA, voffA); PG8_STAGE(PG8_SB(0, 1), cB + hstep, voffB); PG8_STAGE(PG8_SA(0, 1), cA + hstep, voffA);
        if (wr == 1) PG8_BAR;
        PG8_WAIT_V(4); PG8_BAR;
        PG8_STAGE(PG8_SB(1, 0), cB + kstep, voffB); PG8_STAGE(PG8_SA(1, 0), cA + kstep, voffA); PG8_STAGE(PG8_SB(1, 1), cB + hstep + kstep, voffB);
        PG8_WAIT_V(6); PG8_BAR;
    }
    for (;;) {
        const bool has_next = S.next(ui + 1, nxt);
        const char* nA = has_next ? (const char*)g.A + (size_t)nxt.pm * tstep : cA; const char* nB = has_next ? (const char*)g.Bt + (size_t)nxt.pn * tstep : cB;
#define PG8_KPAIR(MM) { \
            const bool last = (t == nt - 2); \
            const char* a1 = cA + (size_t)(t + 1) * kstep; \
            const char* a2 = last ? nA : cA + (size_t)(t + 2) * kstep; const char* b2 = last ? nB : cB + (size_t)(t + 2) * kstep; \
            const char* a3 = a2 + kstep; const char* b3 = b2 + kstep; \
            if (last && has_next) S.a_ready(nxt); \
            PG8_LDB(B0, 0, 0); PG8_LDB(B1, 0, 1); PG8_SCHED; PG8_LDA(At, 0, 0); PG8_STAGE(PG8_SA(1, 1), a1 + hstep, voffA); \
            PG8_WAIT_V(8); PG8_WAIT_L(0); PG8_BAR; MM(0, 0, At, B0); MM(0, 1, At, B1); PG8_BAR; PG8_SCHED; \
            PG8_LDA(At, 0, 1); PG8_STAGE(PG8_SB(0, 0), b2, voffB); PG8_STAGE(PG8_SB(0, 1), b2 + hstep, voffB); PG8_STAGE(PG8_SA(0, 0), a2, voffA); \
            PG8_WAIT_V(8); PG8_WAIT_L(0); PG8_BAR; MM(1, 0, At, B0); MM(1, 1, At, B1); PG8_BAR; PG8_SCHED; \
            PG8_LDB(B0, 1, 0); PG8_LDB(B1, 1, 1); PG8_SCHED; PG8_LDA(At, 1, 0); PG8_STAGE(PG8_SA(0, 1), a2 + hstep, voffA); \
            PG8_WAIT_V(8); PG8_WAIT_L(0); PG8_BAR; PG8_MMA(0, 0, At, B0); PG8_MMA(0, 1, At, B1); PG8_BAR; PG8_SCHED; \
            PG8_LDA(At, 1, 1); PG8_STAGE(PG8_SB(1, 0), b3, voffB); PG8_STAGE(PG8_SB(1, 1), b3 + hstep, voffB); PG8_STAGE(PG8_SA(1, 0), a3, voffA); \
            PG8_WAIT_V(8); PG8_WAIT_L(0); PG8_BAR; PG8_MMA(1, 0, At, B0); PG8_MMA(1, 1, At, B1); PG8_BAR; PG8_SCHED; }
        { const int t = 0; PG8_KPAIR(PG8_MMA0) }
        for (int t = 2; t < nt; t += 2) PG8_KPAIR(PG8_MMA)
        if constexpr (ALIGN_EPI) { if (wr == 0) PG8_BAR; }
        if constexpr (!Epi::AFTER_DRAIN) { E(acc, cur, wr, wc, fr, fq); S.done(cur); }
        if (!has_next) break;
        cur = nxt; cA = nA; cB = nB; ++ui;
        if constexpr (ALIGN_EPI) { if (wr == 1) PG8_BAR; }
    }
    PG8_WAIT_V(0);
    if constexpr (!ALIGN_EPI) { if (wr == 0) PG8_BAR; }
    PG8_BAR;
    if constexpr (Epi::AFTER_DRAIN) { E.fused(acc, cur, wr, wc, fr, fq, lds, wid, lane); S.done(cur); }
#undef PG8_SA
#undef PG8_SB
#undef PG8_STAGE
#undef PG8_LDA
#undef PG8_LDB
#undef PG8_MMA
#undef PG8_MMA0
#undef PG8_KPAIR
#undef PG8_WAIT_V
#undef PG8_WAIT_L
#undef PG8_BAR
#undef PG8_SCHED
}
}

namespace pg8 {
typedef unsigned u32x2 __attribute__((ext_vector_type(2)));
__device__ __forceinline__ float sigm(float x) { return __builtin_amdgcn_rcpf(1.0f + __builtin_amdgcn_exp2f(-1.4426950409f * x)); }
__device__ __forceinline__ float silu_f(float x) { return x * sigm(x); }
__device__ __forceinline__ float gelu_tanh_f(float x) { return x * sigm(1.5957691216f * (x + 0.044715f * x * x * x)); }
__device__ __forceinline__ float bf2f(unsigned short b) { return __uint_as_float(((unsigned)b) << 16); }

template <bool SCALED> struct EpiSwiGLU {
    static constexpr bool PERM = true, AFTER_DRAIN = false;
    bf16_t* O; int ldc; const PG8_LAS float* rs;
    __device__ __forceinline__ void operator()(const f32x4 (&acc)[2][2][4][2], const Unit& u, int wr, int wc, int fr, int fq) const {
        const int row0 = u.pm * BM + wr * 64 + fr, col0 = u.pn * HALF + wc * 32 + 8 * fq;
#pragma unroll
        for (int ai = 0; ai < 2; ++ai)
#pragma unroll
            for (int m = 0; m < 4; ++m) {
                bf16_t* rowp = O + (size_t)(row0 + ai * HALF + m * 16) * ldc + col0;
                f32x4 g0 = acc[ai][0][m][0], g1 = acc[ai][0][m][1], u0 = acc[ai][1][m][0], u1 = acc[ai][1][m][1];
                if (SCALED) { const float r = rs[ai * HALF + wr * 64 + m * 16 + fr]; g0 = g0 * r; g1 = g1 * r; u0 = u0 * r; u1 = u1 * r; }
                u32x4 w;
                w.x = cvt_pk_bf16(silu_f(g0[0]) * u0[0], silu_f(g0[1]) * u0[1]); w.y = cvt_pk_bf16(silu_f(g0[2]) * u0[2], silu_f(g0[3]) * u0[3]);
                w.z = cvt_pk_bf16(silu_f(g1[0]) * u1[0], silu_f(g1[1]) * u1[1]); w.w = cvt_pk_bf16(silu_f(g1[2]) * u1[2], silu_f(g1[3]) * u1[3]);
                *(u32x4*)rowp = w;
            }
    }
};
template <bool NORM> struct EpiResid {
    static constexpr bool PERM = false, AFTER_DRAIN = false;
    const float* base; float* out; int ldc; float scale; bf16_t* xb; float* ssq;
    __device__ __forceinline__ void operator()(const f32x4 (&acc)[2][2][4][2], const Unit& u, int wr, int wc, int fr, int fq) const {
        int row0 = u.pm * BM + wr * 64 + fr, col0 = u.pn * BM + wc * 32 + 4 * fq;
        asm volatile("" : "+v"(row0), "+v"(col0));
        f32x4 b[2][2][2][2];
#pragma unroll
        for (int ch = 0; ch <= 4; ++ch) {
            if (ch < 4) {
#pragma unroll
                for (int mm = 0; mm < 2; ++mm) { const size_t off = (size_t)(row0 + (ch >> 1) * HALF + ((ch & 1) * 2 + mm) * 16) * ldc + col0;
#pragma unroll
                    for (int bj = 0; bj < 2; ++bj)
#pragma unroll
                        for (int n = 0; n < 2; ++n) b[ch & 1][mm][bj][n] = *(const f32x4*)(base + off + bj * HALF + n * 16); }
            }
            asm volatile("" ::: "memory");
            if (ch > 0) {
                const int pc = ch - 1, ai = pc >> 1;
#pragma unroll
                for (int mm = 0; mm < 2; ++mm) { const int m = (pc & 1) * 2 + mm, row = row0 + ai * HALF + m * 16; const size_t off = (size_t)row * ldc + col0;
                    float s = 0.f;
#pragma unroll
                    for (int bj = 0; bj < 2; ++bj)
#pragma unroll
                        for (int n = 0; n < 2; ++n) {
                            const f32x4 o = b[pc & 1][mm][bj][n] + acc[ai][bj][m][n] * scale;
                            *(f32x4*)(out + off + bj * HALF + n * 16) = o;
                            if (NORM) { s += (o[0] * o[0] + o[1] * o[1]) + (o[2] * o[2] + o[3] * o[3]);
                                u32x2 w; w.x = cvt_pk_bf16(o[0], o[1]); w.y = cvt_pk_bf16(o[2], o[3]); *(u32x2*)(xb + off + bj * HALF + n * 16) = w; }
                        }
                    if (NORM) { s += __shfl_xor(s, 16); s += __shfl_xor(s, 32); ssq[(size_t)row * 32 + u.pn * 4 + wc] = s; }
                }
            }
            asm volatile("" ::: "memory");
        }
    }
};
struct EpiMix {
    static constexpr bool PERM = true, AFTER_DRAIN = false;
    bf16_t *Q, *K, *V, *U, *Z, *G; const float* gbias; float* stats; const PG8_LAS float* rs;
    template <int MODE> __device__ __forceinline__ void body(const f32x4 (&acc)[2][2][4][2], bf16_t* base, int ld, int row0, int cin, int rl0, int fq, const float* bp, float* sbase) const {
        f32x4 bv[2][2];
#pragma unroll
        for (int bj = 0; bj < 2; ++bj)
#pragma unroll
            for (int n = 0; n < 2; ++n) bv[bj][n] = (MODE == 3) ? *(const f32x4*)(bp + bj * HALF + 4 * n) : (f32x4){0.f, 0.f, 0.f, 0.f};
        float S1[2][4], S2[2][4];
#pragma unroll
        for (int ai = 0; ai < 2; ++ai)
#pragma unroll
            for (int m = 0; m < 4; ++m) {
                bf16_t* rowp = base + (size_t)(row0 + ai * HALF + m * 16) * ld + cin;
                const float rsv = rs[ai * HALF + rl0 + m * 16];
                float s1 = 0.f, s2 = 0.f;
#pragma unroll
                for (int bj = 0; bj < 2; ++bj) {
                    f32x4 v0 = acc[ai][bj][m][0] * rsv + bv[bj][0], v1 = acc[ai][bj][m][1] * rsv + bv[bj][1];
                    if (MODE == 1 || MODE == 2) {
#pragma unroll
                        for (int e = 0; e < 4; ++e) { v0[e] = gelu_tanh_f(v0[e]); v1[e] = gelu_tanh_f(v1[e]); }
                    } else if (MODE == 3) {
#pragma unroll
                        for (int e = 0; e < 4; ++e) { v0[e] = sigm(v0[e]); v1[e] = sigm(v1[e]); }
                    }
                    if (MODE == 2) {
#pragma unroll
                        for (int e = 0; e < 4; ++e) { s1 += v0[e] + v1[e]; s2 += v0[e] * v0[e] + v1[e] * v1[e]; }
                    }
                    u32x4 w; w.x = cvt_pk_bf16(v0[0], v0[1]); w.y = cvt_pk_bf16(v0[2], v0[3]); w.z = cvt_pk_bf16(v1[0], v1[1]); w.w = cvt_pk_bf16(v1[2], v1[3]);
                    *(u32x4*)(rowp + bj * HALF) = w;
                }
                if (MODE == 2) { s1 += __shfl_xor(s1, 16); s1 += __shfl_xor(s1, 32); s2 += __shfl_xor(s2, 16); s2 += __shfl_xor(s2, 32); S1[ai][m] = s1; S2[ai][m] = s2; }
            }
        if (MODE == 2) {
            if (fq == 0) {
#pragma unroll
                for (int ai = 0; ai < 2; ++ai)
#pragma unroll
                    for (int m = 0; m < 4; ++m) { float* sp = sbase + (size_t)(row0 + ai * HALF + m * 16) * 32; sp[0] = S1[ai][m]; sp[1] = S2[ai][m]; }
            }
        }
    }
    __device__ __forceinline__ void operator()(const f32x4 (&acc)[2][2][4][2], const Unit& u, int wr, int wc, int fr, int fq) const {
        const int pn = u.pn; int row0 = u.pm * BM + wr * 64 + fr, cin = wc * 32 + 8 * fq, rl0 = wr * 64 + fr;
        asm volatile("" : "+v"(row0), "+v"(cin), "+v"(rl0));
        if (pn < 4) body<0>(acc, Q + pn * BM, 1024, row0, cin, rl0, fq, nullptr, nullptr);
        else if (pn < 6) body<0>(acc, pn == 4 ? K : V, 256, row0, cin, rl0, fq, nullptr, nullptr);
        else if (pn < 10) body<1>(acc, U + (pn - 6) * BM, 1024, row0, cin, rl0, fq, nullptr, nullptr);
        else if (pn < 14) body<2>(acc, Z + (pn - 10) * BM, 1024, row0, cin, rl0, fq, nullptr, stats + ((pn - 10) * 4 + wc) * 2);
        else body<3>(acc, G + (pn - 14) * BM, 4096, row0, cin, rl0, fq, gbias + (pn - 14) * BM + cin, nullptr);
    }
};
template <bool SECOND> struct EpiGate {
    static constexpr bool PERM = true, AFTER_DRAIN = false;
    const bf16_t* G; bf16_t* T;
    __device__ __forceinline__ void operator()(const f32x4 (&acc)[2][2][4][2], const Unit& u, int wr, int wc, int fr, int fq) const {
        int row0 = u.pm * BM + wr * 64 + fr, col0 = u.pn * BM + wc * 32 + 8 * fq;
        asm volatile("" : "+v"(row0), "+v"(col0));
        u32x4 gw[2][2][2], tw[2][2][2];
#pragma unroll
        for (int ch = 0; ch <= 4; ++ch) {
            if (ch < 4) {
#pragma unroll
                for (int mm = 0; mm < 2; ++mm) { const size_t row = (size_t)(row0 + (ch >> 1) * HALF + ((ch & 1) * 2 + mm) * 16);
#pragma unroll
                    for (int bj = 0; bj < 2; ++bj) { const int c = col0 + bj * HALF;
                        gw[ch & 1][mm][bj] = *(const u32x4*)(G + row * 4096 + (SECOND ? 2048 : 0) + c);
                        if (SECOND) tw[ch & 1][mm][bj] = *(const u32x4*)(T + row * 2048 + c); } }
            }
            asm volatile("" ::: "memory");
            if (ch > 0) {
                const int pc = ch - 1, ai = pc >> 1;
#pragma unroll
                for (int mm = 0; mm < 2; ++mm) { const int m = (pc & 1) * 2 + mm; const size_t row = (size_t)(row0 + ai * HALF + m * 16);
#pragma unroll
                    for (int bj = 0; bj < 2; ++bj) { const int c = col0 + bj * HALF;
                        const f32x4 a0 = acc[ai][bj][m][0], a1 = acc[ai][bj][m][1];
                        float o[8];
#pragma unroll
                        for (int e = 0; e < 4; ++e) {
                            const unsigned gwe = gw[pc & 1][mm][bj][e], twe = SECOND ? tw[pc & 1][mm][bj][e] : 0u;
                            const float glo = __uint_as_float(gwe << 16), ghi = __uint_as_float(gwe & 0xffff0000u);
                            const float tlo = __uint_as_float(twe << 16), thi = __uint_as_float(twe & 0xffff0000u);
                            const float alo = (e < 2) ? a0[2 * e] : a1[2 * e - 4], ahi = (e < 2) ? a0[2 * e + 1] : a1[2 * e - 3];
                            o[2 * e] = tlo + glo * alo; o[2 * e + 1] = thi + ghi * ahi;
                        }
                        u32x4 w; w.x = cvt_pk_bf16(o[0], o[1]); w.y = cvt_pk_bf16(o[2], o[3]); w.z = cvt_pk_bf16(o[4], o[5]); w.w = cvt_pk_bf16(o[6], o[7]);
                        *(u32x4*)(T + row * 2048 + c) = w;
                    } }
            }
            asm volatile("" ::: "memory");
        }
    }
};
}

namespace cg = cooperative_groups;
#define LAS __attribute__((address_space(3)))
typedef unsigned short bf16;
typedef float f32x4 __attribute__((ext_vector_type(4)));
typedef unsigned v4u __attribute__((ext_vector_type(4)));
typedef unsigned v2u __attribute__((ext_vector_type(2)));
typedef short bf16x8 __attribute__((ext_vector_type(8)));
typedef short s16x4 __attribute__((ext_vector_type(4)));

constexpr int NWAVES = 8;
constexpr int BATCH = 8, SEQ = 2048, D = 2048, FF = 5632, M = BATCH * SEQ;
constexpr int AW = 1024, KVW = 256, SW = 1024, NMIX = 3584 + 4096;
constexpr float EPS = 1e-6f;
constexpr size_t MiB = 1u << 20;
constexpr size_t WS_STATS = 0, WS_WSM = 2 * MiB, WS_WGU1 = 3 * MiB, WS_WD1 = 47 * MiB, WS_WGU2 = 69 * MiB, WS_WD2 = 113 * MiB, WS_WMIX = 135 * MiB,
                 WS_PA = 165 * MiB, WS_PB = 169 * MiB, WS_WOUT = 173 * MiB, WS_H = 181 * MiB, WS_ACT = 245 * MiB,
                 WS_Q = 245 * MiB, WS_K = 277 * MiB, WS_V = 285 * MiB, WS_U = 293 * MiB, WS_Z = 325 * MiB, WS_G = 357 * MiB, WS_SSQ = 485 * MiB, WS_END = 487 * MiB,
                 WS_T = WS_WGU1;
static_assert(WS_WGU1 + (size_t)2 * FF * D * 2 == WS_WD1 && WS_WD1 + (size_t)D * FF * 2 == WS_WGU2 && WS_WMIX + (size_t)NMIX * D * 2 == WS_PA && WS_H + (size_t)M * D * 2 == WS_ACT &&
              WS_ACT + (size_t)M * FF * 2 <= WS_END && WS_G + (size_t)M * 4096 * 2 == WS_SSQ && WS_T + (size_t)M * D * 2 <= WS_WGU2, "d_ws map");
constexpr size_t WS_BAR = 2 * MiB + 768 * 1024, BAR_BYTES = 16384;
constexpr int MISC_OFF = 131072 + 1024, RS_OFF = 131072 + 2048;
constexpr int LDS_BYTES = 147456;

enum { I_X = 0, I_N1, I_WG1, I_WU1, I_WD1, I_NMIX, I_WIN, I_SINK, I_LNG, I_LNB, I_WS, I_BS, I_PA, I_PB, I_WGATE, I_BGATE, I_WOUT, I_N2, I_WG2, I_WU2, I_WD2, I_NF, N_IN };

struct Args { const float* in[N_IN]; float* out; unsigned char* ws; int ph_lo, ph_hi; };

__device__ __forceinline__ unsigned f2bf(float f) { unsigned u = __builtin_bit_cast(unsigned, f); return (u + 0x7fffu + ((u >> 16) & 1u)) >> 16; }
__device__ __forceinline__ unsigned pk2(float lo, float hi) { typedef float f2_t __attribute__((ext_vector_type(2))); typedef __bf16 b2_t __attribute__((ext_vector_type(2))); const f2_t v = {lo, hi}; return __builtin_bit_cast(unsigned, __builtin_convertvector(v, b2_t)); }
__device__ __forceinline__ float wave_sum(float v) {
#pragma unroll
    for (int o = 1; o < 64; o <<= 1) v += __shfl_xor(v, o);
    return v;
}
#define LDS_WAIT() asm volatile("s_waitcnt lgkmcnt(0)" ::: "memory")

#define XB_TMO      128
#define XB_XCNT(j)  (256  + 64 * (j))
#define XB_XSUB(j)  (1280 + 64 * (j))
#define XB_XGEN(j)  (2304 + 64 * (j))
#define XB_TOP      3328
#define XB_TOPGEN   3392
#define XCD_BAR_WORDS 3456
#define XB_SPIN_CAP (1u << 18)

__device__ __forceinline__ unsigned xb_ld(unsigned* p)              { return __hip_atomic_load(p, __ATOMIC_RELAXED, __HIP_MEMORY_SCOPE_AGENT); }
__device__ __forceinline__ unsigned xb_add(unsigned* p, unsigned v) { return __hip_atomic_fetch_add(p, v, __ATOMIC_RELAXED, __HIP_MEMORY_SCOPE_AGENT); }
__device__ __forceinline__ unsigned xb_xcc_id() { return (unsigned)__builtin_amdgcn_s_getreg((3 << 11) | 20) & 0xFu; }
#define XB_SPIN(cond, bar) do { unsigned _sp = 0; while (cond) { __builtin_amdgcn_s_sleep(1); \
    if ((++_sp & 255u) == 0u) { if (xb_ld(&(bar)[XB_TMO])) break; if (_sp > XB_SPIN_CAP) { atomicAdd(&(bar)[XB_TMO], 1u); break; } } } } while (0)

struct XcdBarrier {
    unsigned* bar; unsigned x;
    volatile LAS unsigned* st;
};

__device__ __forceinline__ XcdBarrier xcd_barrier_post(unsigned* bar, volatile LAS unsigned* st) {
    XcdBarrier b; b.bar = bar; b.x = xb_xcc_id(); b.st = st;
    if (threadIdx.x == 0) (void)xb_add(&bar[XB_XCNT(b.x)], 1u);
    return b;
}
__device__ __forceinline__ void xcd_barrier_complete(unsigned* bar, unsigned x, unsigned& nloc, unsigned& nx) {
    const unsigned G = gridDim.x * gridDim.y * gridDim.z;
    unsigned sum, cnt, mine, sp = 0u;
    for (;;) {
        sum = 0u; cnt = 0u; mine = 0u;
#pragma unroll
        for (unsigned j = 0; j < 16; ++j) { const unsigned c = xb_ld(&bar[XB_XCNT(j)]); sum += c; cnt += (c > 0u) ? 1u : 0u; mine = (j == x) ? c : mine; }
        if (sum == G) break;
        __builtin_amdgcn_s_sleep(1);
        if ((++sp & 255u) == 0u) { if (xb_ld(&bar[XB_TMO])) break; if (sp > XB_SPIN_CAP) { atomicAdd(&bar[XB_TMO], 1u); break; } }
    }
    nloc = mine > 0u ? mine : 1u; nx = cnt > 0u ? cnt : 1u;
}

__device__ __forceinline__ void xcd_barrier(const XcdBarrier& b) {
    asm volatile("s_waitcnt vmcnt(0)" ::: "memory");
    __syncthreads();
    if (threadIdx.x == 0) {
        unsigned* bar = b.bar;
        __builtin_amdgcn_s_waitcnt(0);
        unsigned nloc = b.st[0], nx = b.st[1];
        if (nloc == 0u) { xcd_barrier_complete(bar, b.x, nloc, nx); b.st[0] = nloc; b.st[1] = nx; }
        const unsigned old = xb_add(&bar[XB_XSUB(b.x)], 1u);
        const unsigned gen = old / nloc;
        if (old + 1u == (gen + 1u) * nloc) {
            __builtin_amdgcn_fence(__ATOMIC_RELEASE, "agent");
            asm volatile("s_waitcnt vmcnt(0)" ::: "memory");
            const unsigned og = xb_add(&bar[XB_TOP], 1u);
            const unsigned tg = og / nx;
            if (og + 1u == (tg + 1u) * nx) xb_add(&bar[XB_TOPGEN], 1u);
            else XB_SPIN(xb_ld(&bar[XB_TOPGEN]) == tg, bar);
            __builtin_amdgcn_fence(__ATOMIC_ACQUIRE, "agent");
            xb_add(&bar[XB_XGEN(b.x)], 1u);
            asm volatile("s_waitcnt vmcnt(0)" ::: "memory");
        } else {
            XB_SPIN(xb_ld(&bar[XB_XGEN(b.x)]) == gen, bar);
            __builtin_amdgcn_fence(__ATOMIC_ACQUIRE, "agent");
            asm volatile("s_waitcnt vmcnt(0)" ::: "memory");
        }
    }
    __syncthreads();
}

__device__ __forceinline__ void transpose_item(const float* W, int K, int N, bf16* WT, int mode, int row_off, const float* gain, int item, int lane) {
    const int nblk = N / 64, kb = item / nblk, nb = item % nblk, k0 = 64 * kb, n0 = 64 * nb;
    const int rbase = (mode == 0) ? (row_off + n0) : ((n0 >> 7) * 256 + (n0 & 127) + row_off);
    const float* src = W + (size_t)k0 * N + n0 + lane;
    float v[64];
#pragma unroll
    for (int i = 0; i < 64; ++i) v[i] = src[(size_t)i * N];
    if (gain) {
#pragma unroll
        for (int i = 0; i < 64; ++i) v[i] *= gain[k0 + i];
    }
    bf16* dst = WT + (size_t)(rbase + lane) * K + k0;
#pragma unroll
    for (int c = 0; c < 8; ++c) { v4u o; o.x = pk2(v[8 * c], v[8 * c + 1]); o.y = pk2(v[8 * c + 2], v[8 * c + 3]); o.z = pk2(v[8 * c + 4], v[8 * c + 5]); o.w = pk2(v[8 * c + 6], v[8 * c + 7]);
        *(v4u*)(dst + 8 * c) = o; }
}
template <bool OUT_BF16> __device__ __forceinline__ void rms_rows(const float* X, const float* gain, void* out, int gw, int ngw, int lane) {
    int m = gw;
    for (; m + ngw < M; m += 2 * ngw) {
        const f32x4* xr0 = (const f32x4*)(X + (size_t)m * D) + lane; const f32x4* xr1 = (const f32x4*)(X + (size_t)(m + ngw) * D) + lane;
        f32x4 v0[8], v1[8]; float s0 = 0.f, s1 = 0.f;
#pragma unroll
        for (int j = 0; j < 8; ++j) { v0[j] = xr0[64 * j]; v1[j] = xr1[64 * j]; }
#pragma unroll
        for (int j = 0; j < 8; ++j) { s0 += (v0[j].x * v0[j].x + v0[j].y * v0[j].y) + (v0[j].z * v0[j].z + v0[j].w * v0[j].w); s1 += (v1[j].x * v1[j].x + v1[j].y * v1[j].y) + (v1[j].z * v1[j].z + v1[j].w * v1[j].w); }
        const float rs0 = 1.0f / sqrtf(wave_sum(s0) * (1.0f / D) + EPS), rs1 = 1.0f / sqrtf(wave_sum(s1) * (1.0f / D) + EPS);
#pragma unroll
        for (int j = 0; j < 8; ++j) {
            const f32x4 g = ((const f32x4*)gain)[lane + 64 * j]; const f32x4 o0 = v0[j] * rs0 * g, o1 = v1[j] * rs1 * g;
            if (OUT_BF16) { v2u w0, w1; w0.x = pk2(o0.x, o0.y); w0.y = pk2(o0.z, o0.w); w1.x = pk2(o1.x, o1.y); w1.y = pk2(o1.z, o1.w);
                ((v2u*)((bf16*)out + (size_t)m * D))[lane + 64 * j] = w0; ((v2u*)((bf16*)out + (size_t)(m + ngw) * D))[lane + 64 * j] = w1; }
            else { ((f32x4*)((float*)out + (size_t)m * D))[lane + 64 * j] = o0; ((f32x4*)((float*)out + (size_t)(m + ngw) * D))[lane + 64 * j] = o1; }
        }
    }
    for (; m < M; m += ngw) {
        const f32x4* xr = (const f32x4*)(X + (size_t)m * D) + lane;
        f32x4 v[8]; float s = 0.f;
#pragma unroll
        for (int j = 0; j < 8; ++j) { v[j] = xr[64 * j]; s += (v[j].x * v[j].x + v[j].y * v[j].y) + (v[j].z * v[j].z + v[j].w * v[j].w); }
        const float rs = 1.0f / sqrtf(wave_sum(s) * (1.0f / D) + EPS);
#pragma unroll
        for (int j = 0; j < 8; ++j) {
            const f32x4 g = ((const f32x4*)gain)[lane + 64 * j]; const f32x4 o = v[j] * rs * g;
            if (OUT_BF16) { v2u w; w.x = pk2(o.x, o.y); w.y = pk2(o.z, o.w); ((v2u*)((bf16*)out + (size_t)m * D))[lane + 64 * j] = w; }
            else ((f32x4*)((float*)out + (size_t)m * D))[lane + 64 * j] = o;
        }
    }
}

constexpr int KS_LD = 72, VT_LD = 264, KS_BYTES = 256 * KS_LD * 2;
template <bool FULL> __device__ __forceinline__ void attn_qtile(const LAS bf16* Ks, const LAS bf16* Vt, const bf16* QO, bf16* Oout, int row_cur, int h, int qt, int fr, int fq, float slope8, float sink8) {
    const int qi = qt * 16 + fr, kt0 = qt < 6 ? qt : 6;
    const bf16* qrow = QO + (size_t)(row_cur + qi) * AW + h * 64; bf16* orow = Oout + (size_t)(row_cur + qi) * AW + h * 64;
    bf16x8 qf[2]; qf[0] = *(const bf16x8*)(qrow + fq * 8); qf[1] = *(const bf16x8*)(qrow + 32 + fq * 8);
    const int d0 = 128 + qi - kt0 * 16 - fq * 4;
    const int e0 = 128 - kt0 * 16 - fq * 4;
    const float a0 = -slope8 * (float)d0;
    f32x4 S[10];
#pragma unroll
    for (int j = 0; j < 10; ++j) {
#pragma unroll
        for (int i = 0; i < 4; ++i) S[j][i] = fmaf(slope8, (float)(16 * j + i), a0);
#pragma unroll
        for (int ks = 0; ks < 2; ++ks) {
            const bf16x8 kf = *(const LAS bf16x8*)(Ks + ((kt0 + j) * 16 + fr) * KS_LD + ks * 32 + fq * 8);
            S[j] = __builtin_amdgcn_mfma_f32_16x16x32_bf16(kf, qf[ks], S[j], 0, 0, 0);
        }
    }
    float mx = sink8;
#pragma unroll
    for (int j = 0; j < 10; ++j)
#pragma unroll
        for (int i = 0; i < 4; ++i) {
            if (FULL || j < 2 || j > 7) {
                const int c = 16 * j + i; bool ok = (unsigned)(d0 - c) < 128u; if (FULL) ok = ok && (c >= e0);
                S[j][i] = ok ? S[j][i] : -1e30f;
            }
            mx = fmaxf(mx, S[j][i]);
        }
    mx = fmaxf(mx, __shfl_xor(mx, 16)); mx = fmaxf(mx, __shfl_xor(mx, 32));
    const float C = 0.125f * 1.4426950409f, nm = -mx * C;
    float sum = 0.f;
#pragma unroll
    for (int j = 0; j < 10; ++j)
#pragma unroll
        for (int i = 0; i < 4; ++i) { const float p = __builtin_amdgcn_exp2f(fmaf(S[j][i], C, nm)); S[j][i] = p; sum += p; }
    sum += __shfl_xor(sum, 16); sum += __shfl_xor(sum, 32);
    sum += __builtin_amdgcn_exp2f(fmaf(sink8, C, nm));
    const float inv = 1.0f / sum;
    f32x4 O[4];
#pragma unroll
    for (int dt = 0; dt < 4; ++dt) O[dt] = (f32x4){0.f, 0.f, 0.f, 0.f};
#pragma unroll
    for (int kk = 0; kk < 5; ++kk) {
        v4u pw; pw.x = pk2(S[2 * kk][0], S[2 * kk][1]); pw.y = pk2(S[2 * kk][2], S[2 * kk][3]); pw.z = pk2(S[2 * kk + 1][0], S[2 * kk + 1][1]); pw.w = pk2(S[2 * kk + 1][2], S[2 * kk + 1][3]);
        const bf16x8 pb = __builtin_bit_cast(bf16x8, pw);
#pragma unroll
        for (int dt = 0; dt < 4; ++dt) {
            const LAS bf16* vp = Vt + (dt * 16 + fr) * VT_LD + (kt0 + 2 * kk) * 16 + fq * 4;
            const v2u a0v = *(const LAS v2u*)vp, a1v = *(const LAS v2u*)(vp + 16);
            v4u aw; aw.x = a0v.x; aw.y = a0v.y; aw.z = a1v.x; aw.w = a1v.y;
            O[dt] = __builtin_amdgcn_mfma_f32_16x16x32_bf16(__builtin_bit_cast(bf16x8, aw), pb, O[dt], 0, 0, 0);
        }
    }
#pragma unroll
    for (int dt = 0; dt < 4; ++dt) { v2u w; w.x = pk2(O[dt][0] * inv, O[dt][1] * inv); w.y = pk2(O[dt][2] * inv, O[dt][3] * inv); *(v2u*)(orow + dt * 16 + fq * 4) = w; }
}

__device__ __forceinline__ void attn_unit(LAS unsigned char* lds, const bf16* QO, bf16* Oout, const bf16* Kb, const bf16* Vb, const float* sinks, int unit, int tid, int wave, int lane) {
    const int b = unit >> 6, blk = (unit >> 2) & 15, kvh = unit & 3;
    const int row_cur = b * SEQ + blk * 128;
    LAS bf16* Ks = (LAS bf16*)lds; LAS bf16* Vt = (LAS bf16*)(lds + KS_BYTES);
    __syncthreads();
#pragma unroll
    for (int i = 0; i < 4; ++i) {
        const int idx = tid + i * 512, key = idx >> 3, ch = idx & 7; const bool ok = (blk > 0) || (key >= 128);
        v4u v = (v4u){0u, 0u, 0u, 0u}; if (ok) v = *(const v4u*)(Kb + (size_t)(row_cur - 128 + key) * KVW + kvh * 64 + ch * 8);
        *(LAS v4u*)(Ks + key * KS_LD + ch * 8) = v;
    }
#pragma unroll
    for (int i = 0; i < 4; ++i) {
        const int idx = tid + i * 512, key = idx & 255, ch = idx >> 8; const bool ok = (blk > 0) || (key >= 128);
        v4u v = (v4u){0u, 0u, 0u, 0u}; if (ok) v = *(const v4u*)(Vb + (size_t)(row_cur - 128 + key) * KVW + kvh * 64 + ch * 8);
#pragma unroll
        for (int e = 0; e < 4; ++e) { Vt[(ch * 8 + 2 * e) * VT_LD + key] = (bf16)(v[e] & 0xffffu); Vt[(ch * 8 + 2 * e + 1) * VT_LD + key] = (bf16)(v[e] >> 16); }
    }
    __syncthreads();
    const int h = kvh * 4 + (wave >> 1), fr = lane & 15, fq = lane >> 4;
    const float slope8 = 8.0f * __builtin_amdgcn_exp2f(-0.5f * (float)(h + 1)), sink8 = 8.0f * sinks[h];
    if (blk == 0) { for (int qq = 0; qq < 4; ++qq) attn_qtile<true>(Ks, Vt, QO, Oout, row_cur, h, (wave & 1) * 4 + qq, fr, fq, slope8, sink8); }
    else          { for (int qq = 0; qq < 4; ++qq) attn_qtile<false>(Ks, Vt, QO, Oout, row_cur, h, (wave & 1) * 4 + qq, fr, fq, slope8, sink8); }
}

constexpr int ZT_LD = 136, ZT_BYTES = 256 * ZT_LD * 2;
__device__ __forceinline__ void sgu_unit(LAS unsigned char* lds, const bf16* U, bf16* Uout, const bf16* Zb, const float* stats, const float* lng, const float* lnb, const bf16* wsm, const float* bs,
                                         int unit, int tid, int wave, int lane) {
    const int b = unit >> 6, chunk = (unit >> 2) & 15, gq = unit & 3;
    const int row0 = b * SEQ + chunk * 128, colbase = gq * 256;
    LAS bf16* zt = (LAS bf16*)lds; LAS float* st = (LAS float*)(lds + ZT_BYTES);
    __syncthreads();
    if (tid < 128) {
        const f32x4* sp = (const f32x4*)(stats + (size_t)(row0 + tid) * 32); float s1 = 0.f, s2 = 0.f;
#pragma unroll
        for (int p = 0; p < 8; ++p) { const f32x4 v = sp[p]; s1 += v.x + v.z; s2 += v.y + v.w; }
        const float mu = s1 * (1.0f / SW), var = fmaxf(s2 * (1.0f / SW) - mu * mu, 0.f);
        st[2 * tid] = mu; st[2 * tid + 1] = 1.0f / sqrtf(var + EPS);
    }
    __syncthreads();
#pragma unroll 2
    for (int i = 0; i < 8; ++i) {
        const int idx = tid + i * 512, s = idx & 127, c8 = idx >> 7;
        const v4u z = *(const v4u*)(Zb + (size_t)(row0 + s) * SW + colbase + c8 * 8);
        const float mu = st[2 * s], rstd = st[2 * s + 1];
        const float* gp = lng + colbase + c8 * 8; const float* bp = lnb + colbase + c8 * 8;
#pragma unroll
        for (int e = 0; e < 4; ++e) {
            const float zlo = __uint_as_float(z[e] << 16), zhi = __uint_as_float(z[e] & 0xffff0000u);
            const unsigned zp = pk2((zlo - mu) * rstd * gp[2 * e] + bp[2 * e], (zhi - mu) * rstd * gp[2 * e + 1] + bp[2 * e + 1]);
            zt[(c8 * 8 + 2 * e) * ZT_LD + s] = (bf16)(zp & 0xffffu);
            zt[(c8 * 8 + 2 * e + 1) * ZT_LD + s] = (bf16)(zp >> 16);
        }
    }
    __syncthreads();
    const int fr = lane & 15, fq = lane >> 4, t = wave * 16 + fr, nks = (wave >> 1) + 1;
    f32x4 acc[16];
#pragma unroll
    for (int ct = 0; ct < 16; ++ct) acc[ct] = (f32x4){0.f, 0.f, 0.f, 0.f};
    for (int ks = 0; ks < nks; ++ks) {
        bf16x8 wb[4];
#pragma unroll
        for (int gi = 0; gi < 4; ++gi) wb[gi] = *(const bf16x8*)(wsm + ((size_t)((gq * 4 + gi) * 128 + t)) * 128 + ks * 32 + fq * 8);
#pragma unroll
        for (int ct = 0; ct < 16; ++ct) {
            const bf16x8 za = *(const LAS bf16x8*)(zt + (ct * 16 + fr) * ZT_LD + ks * 32 + fq * 8);
            acc[ct] = __builtin_amdgcn_mfma_f32_16x16x32_bf16(za, wb[ct >> 2], acc[ct], 0, 0, 0);
        }
    }
    const bf16* urow = U + (size_t)(row0 + t) * SW + colbase + fq * 4; bf16* uorow = Uout + (size_t)(row0 + t) * SW + colbase + fq * 4;
#pragma unroll
    for (int ct = 0; ct < 16; ++ct) {
        const float bias = bs[(gq * 4 + (ct >> 2)) * 128 + t];
        const v2u uw = *(const v2u*)(urow + ct * 16);
        const float u0 = __uint_as_float(uw.x << 16), u1 = __uint_as_float(uw.x & 0xffff0000u), u2 = __uint_as_float(uw.y << 16), u3 = __uint_as_float(uw.y & 0xffff0000u);
        v2u w; w.x = pk2(u0 * (acc[ct][0] + bias), u1 * (acc[ct][1] + bias)); w.y = pk2(u2 * (acc[ct][2] + bias), u3 * (acc[ct][3] + bias));
        *(v2u*)(uorow + ct * 16) = w;
    }
}

__device__ __forceinline__ void panel_scales(LAS unsigned char* lds, const float* ssq, int pm, int tid) {
    const int r = tid >> 1, h = tid & 1;
    const f32x4* p = (const f32x4*)(ssq + (size_t)(pm * 256 + r) * 32 + h * 16);
    const f32x4 a = p[0], b = p[1], c = p[2], d = p[3];
    float sum = (((a.x + a.y) + (a.z + a.w)) + ((b.x + b.y) + (b.z + b.w))) + (((c.x + c.y) + (c.z + c.w)) + ((d.x + d.y) + (d.z + d.w)));
    sum += __shfl_xor(sum, 1);
    if (h == 0) ((LAS float*)(lds + RS_OFF))[r] = 1.0f / sqrtf(sum * (1.0f / D) + EPS);
    __syncthreads();
}

#ifndef MK_N_LAUNCHES
#define MK_N_LAUNCHES 1
#endif
constexpr int N_PHASES = 12;
constexpr int IT_FF = (D / 64) * (FF / 64), IT_DN = (FF / 64) * (D / 64), IT_WIN = (D / 64) * (3584 / 64), IT_WG = (D / 64) * (4096 / 64), IT_P = (AW / 64) * (D / 64), IT_O = (D / 64) * (D / 64);
constexpr int N_EARLY = 2 * IT_FF + IT_DN + IT_WIN + IT_WG, N_LATE = 2 * IT_P + IT_O + 2 * IT_FF + IT_DN;
static_assert(N_LATE % 8 == 0, "late items are dealt over 8 queue heads");

__global__ void __launch_bounds__(NWAVES * 64, 2) hybrid_fwd(Args args) {
    extern __shared__ __attribute__((aligned(16))) unsigned char lds_raw[];
    LAS unsigned char* lds = (LAS unsigned char*)lds_raw;
    const int tid = threadIdx.x, lane = tid & 63, wave = __builtin_amdgcn_readfirstlane(tid >> 6);
    const int G = gridDim.x, gw = blockIdx.x * NWAVES + wave, ngw = G * NWAVES;
    unsigned char* ws = args.ws;
    const int lo = args.ph_lo, hi = args.ph_hi;
#define IN(k) (lo <= (k) && (k) < hi)
    if (tid < 64) ((LAS unsigned*)(lds + MISC_OFF))[tid] = 0u;
    __syncthreads();
    XcdBarrier bar; bar.bar = (unsigned*)(ws + WS_BAR); bar.x = 0; bar.st = (volatile LAS unsigned*)(lds + MISC_OFF + 32);
    if (hi - lo > 1) bar = xcd_barrier_post((unsigned*)(ws + WS_BAR), (volatile LAS unsigned*)(lds + MISC_OFF + 32));
#define SEAM(k) do { if (IN(k) && IN((k) + 1)) xcd_barrier(bar); } while (0)
    if (lo < 0) cg::this_grid().sync();
    bf16* Hb = (bf16*)(ws + WS_H); bf16* ACT = (bf16*)(ws + WS_ACT); bf16* Tb = (bf16*)(ws + WS_T); float* ssq = (float*)(ws + WS_SSQ);
    bf16 *Qb = (bf16*)(ws + WS_Q), *Kb = (bf16*)(ws + WS_K), *Vb = (bf16*)(ws + WS_V), *Ub = (bf16*)(ws + WS_U), *Zb = (bf16*)(ws + WS_Z), *Gb = (bf16*)(ws + WS_G);
    float* stats = (float*)(ws + WS_STATS); bf16* wsm = (bf16*)(ws + WS_WSM);

    if (IN(0)) {
        for (int it = gw; it < N_EARLY; it += ngw) {
            int r = it;
            if (r < IT_FF) { transpose_item(args.in[I_WG1], D, FF, (bf16*)(ws + WS_WGU1), 1, 0, nullptr, r, lane); continue; } r -= IT_FF;
            if (r < IT_FF) { transpose_item(args.in[I_WU1], D, FF, (bf16*)(ws + WS_WGU1), 1, 128, nullptr, r, lane); continue; } r -= IT_FF;
            if (r < IT_DN) { transpose_item(args.in[I_WD1], FF, D, (bf16*)(ws + WS_WD1), 0, 0, nullptr, r, lane); continue; } r -= IT_DN;
            if (r < IT_WIN) { transpose_item(args.in[I_WIN], D, 3584, (bf16*)(ws + WS_WMIX), 0, 0, args.in[I_NMIX], r, lane); continue; } r -= IT_WIN;
            transpose_item(args.in[I_WGATE], D, 4096, (bf16*)(ws + WS_WMIX), 0, 3584, args.in[I_NMIX], r, lane);
        }
        for (int e = blockIdx.x * 512 + tid; e < 16 * 128 * 128; e += G * 512) { const int s = e & 127, t = (e >> 7) & 127; wsm[e] = (s <= t) ? (bf16)f2bf(args.in[I_WS][e]) : (bf16)0; }
        rms_rows<true>(args.in[I_X], args.in[I_N1], Hb, gw, ngw, lane);
    }
    SEAM(0);
    if (IN(1)) {
        pg8::Gemm g{Hb, (const bf16*)(ws + WS_WGU1), M, 2 * FF, D}; pg8::StaticOrder S; S.init(M, 2 * FF, G, (int)blockIdx.x);
        pg8::EpiSwiGLU<false> E{ACT, FF, nullptr};
        pg8::gemm_phase<pg8::EpiSwiGLU<false>, pg8::StaticOrder, true, true>(lds, g, S, E);
    }
    SEAM(1);
    if (IN(2)) {
        pg8::Gemm g{ACT, (const bf16*)(ws + WS_WD1), M, D, FF}; pg8::StaticOrder S; S.init(M, D, G, (int)blockIdx.x);
        pg8::EpiResid<true> E{args.in[I_X], args.out, D, 0.5f, Hb, ssq};
        pg8::gemm_phase<pg8::EpiResid<true>, pg8::StaticOrder, true, true>(lds, g, S, E);
    }
    SEAM(2);
    if (IN(4)) {
        pg8::Gemm g{Hb, (const bf16*)(ws + WS_WMIX), M, NMIX, D}; pg8::StaticOrder S; S.init(M, NMIX, G, (int)blockIdx.x);
        { pg8::Unit u0; if (S.next(0, u0)) panel_scales(lds, ssq, u0.pm, tid); else __syncthreads(); }
        pg8::EpiMix E{Qb, Kb, Vb, Ub, Zb, Gb, args.in[I_BGATE], stats, (const LAS float*)(lds + RS_OFF)};
        pg8::gemm_phase<pg8::EpiMix, pg8::StaticOrder, true, true>(lds, g, S, E);
        unsigned* qheads = (unsigned*)(ws + WS_BAR + 14336);
        const int myq = (int)(xb_xcc_id() & 7u);
        for (int q = 0; q < 8; ++q) {
            const int qi = (myq + q) & 7;
            for (;;) {
                int t = 0;
                if (lane == 0) t = (int)__hip_atomic_fetch_add(qheads + 64 * qi, 1u, __ATOMIC_RELAXED, __HIP_MEMORY_SCOPE_AGENT);
                t = __builtin_amdgcn_readfirstlane(t);
                if (t >= N_LATE / 8) break;
                int r = t * 8 + qi;
                if (r < IT_P) { transpose_item(args.in[I_PA], AW, D, (bf16*)(ws + WS_PA), 0, 0, nullptr, r, lane); continue; } r -= IT_P;
                if (r < IT_P) { transpose_item(args.in[I_PB], SW, D, (bf16*)(ws + WS_PB), 0, 0, nullptr, r, lane); continue; } r -= IT_P;
                if (r < IT_O) { transpose_item(args.in[I_WOUT], D, D, (bf16*)(ws + WS_WOUT), 0, 0, nullptr, r, lane); continue; } r -= IT_O;
                if (r < IT_FF) { transpose_item(args.in[I_WG2], D, FF, (bf16*)(ws + WS_WGU2), 1, 0, args.in[I_N2], r, lane); continue; } r -= IT_FF;
                if (r < IT_FF) { transpose_item(args.in[I_WU2], D, FF, (bf16*)(ws + WS_WGU2), 1, 128, args.in[I_N2], r, lane); continue; } r -= IT_FF;
                transpose_item(args.in[I_WD2], FF, D, (bf16*)(ws + WS_WD2), 0, 0, nullptr, r, lane);
            }
        }
    }
    SEAM(4);
    if (IN(5)) {
        for (int i = blockIdx.x; i < 1024; i += G) {
            if (i < 512) attn_unit(lds, Qb, Qb, Kb, Vb, args.in[I_SINK], i, tid, wave, lane);
            else sgu_unit(lds, Ub, Ub, Zb, stats, args.in[I_LNG], args.in[I_LNB], wsm, args.in[I_BS], i - 512, tid, wave, lane);
        }
        __syncthreads();
    }
    SEAM(5);
    if (IN(6)) {
        { pg8::Gemm g{Qb, (const bf16*)(ws + WS_PA), M, D, AW}; pg8::StaticOrder S; S.init(M, D, G, (int)blockIdx.x);
          pg8::EpiGate<false> E{Gb, Tb}; pg8::gemm_phase<pg8::EpiGate<false>, pg8::StaticOrder, true, true>(lds, g, S, E); }
        { pg8::Gemm g{Ub, (const bf16*)(ws + WS_PB), M, D, SW}; pg8::StaticOrder S; S.init(M, D, G, (int)blockIdx.x);
          pg8::EpiGate<true> E{Gb, Tb}; pg8::gemm_phase<pg8::EpiGate<true>, pg8::StaticOrder, true, true>(lds, g, S, E); }
    }
    SEAM(6);
    if (IN(7)) {
        pg8::Gemm g{Tb, (const bf16*)(ws + WS_WOUT), M, D, D}; pg8::StaticOrder S; S.init(M, D, G, (int)blockIdx.x);
        pg8::EpiResid<true> E{args.out, args.out, D, 1.0f, Hb, ssq};
        pg8::gemm_phase<pg8::EpiResid<true>, pg8::StaticOrder, true, true>(lds, g, S, E);
    }
    SEAM(7);
    if (IN(9)) {
        pg8::Gemm g{Hb, (const bf16*)(ws + WS_WGU2), M, 2 * FF, D}; pg8::StaticOrder S; S.init(M, 2 * FF, G, (int)blockIdx.x);
        { pg8::Unit u0; if (S.next(0, u0)) panel_scales(lds, ssq, u0.pm, tid); else __syncthreads(); }
        pg8::EpiSwiGLU<true> E{ACT, FF, (const LAS float*)(lds + RS_OFF)};
        pg8::gemm_phase<pg8::EpiSwiGLU<true>, pg8::StaticOrder, true, true>(lds, g, S, E);
    }
    SEAM(9);
    if (IN(10)) {
        pg8::Gemm g{ACT, (const bf16*)(ws + WS_WD2), M, D, FF}; pg8::StaticOrder S; S.init(M, D, G, (int)blockIdx.x);
        pg8::EpiResid<false> E{args.out, args.out, D, 0.5f, nullptr, nullptr};
        pg8::gemm_phase<pg8::EpiResid<false>, pg8::StaticOrder, true, true>(lds, g, S, E);
    }
    SEAM(10);
    if (IN(11)) rms_rows<false>(args.out, args.in[I_NF], args.out, gw, ngw, lane);
#undef IN
#undef SEAM
}

extern "C" void kernel_launch(void* const* d_in, const int* in_sizes, int n_in, void* d_out, int out_size, void* d_ws, size_t ws_size, hipStream_t stream) {
    static int grid = 0;
    if (grid == 0) {
        if (n_in != N_IN || in_sizes[0] != M * D || out_size != M * D || ws_size < WS_END) { fprintf(stderr, "kernel_launch: unexpected shapes (n_in %d, in0 %d, out %d, ws %zu)\n", n_in, n_in > 0 ? in_sizes[0] : -1, out_size, ws_size); grid = -1; return; }
        int dev = 0, cus = 0, per_cu = 0;
        if (hipGetDevice(&dev) != hipSuccess || hipDeviceGetAttribute(&cus, hipDeviceAttributeMultiprocessorCount, dev) != hipSuccess) { grid = -1; return; }
        if (hipFuncSetAttribute((const void*)hybrid_fwd, hipFuncAttributeMaxDynamicSharedMemorySize, LDS_BYTES) != hipSuccess) { fprintf(stderr, "kernel_launch: hipFuncSetAttribute failed\n"); grid = -1; return; }
        if (hipOccupancyMaxActiveBlocksPerMultiprocessor(&per_cu, (const void*)hybrid_fwd, NWAVES * 64, LDS_BYTES) != hipSuccess || per_cu < 1) { fprintf(stderr, "kernel_launch: occupancy query says %d\n", per_cu); per_cu = 1; }
        (void)hipGetLastError();
        grid = (cus / 64) * 64;
        if (grid < 64) { fprintf(stderr, "kernel_launch: needs at least 64 CUs\n"); grid = -1; return; }
        (void)per_cu;
    }
    if (grid < 0) return;
    if (hipMemsetAsync((char*)d_ws + WS_BAR, 0, BAR_BYTES, stream) != hipSuccess) { fprintf(stderr, "kernel_launch: memset failed\n"); return; }
    Args a{};
    for (int i = 0; i < N_IN; ++i) a.in[i] = (const float*)d_in[i];
    a.out = (float*)d_out; a.ws = (unsigned char*)d_ws;
#if MK_N_LAUNCHES == 1
    a.ph_lo = 0; a.ph_hi = N_PHASES;
    void* kargs[] = {&a};
    hipError_t e = hipLaunchCooperativeKernel((const void*)hybrid_fwd, dim3(grid), dim3(NWAVES * 64), kargs, LDS_BYTES, stream);
    if (e != hipSuccess) fprintf(stderr, "kernel_launch: cooperative launch failed: %s (grid %d)\n", hipGetErrorString(e), grid);
#else
    for (int p = 0; p < N_PHASES; ++p) {
        a.ph_lo = p; a.ph_hi = p + 1;
        hipLaunchKernelGGL(hybrid_fwd, dim3(grid), dim3(NWAVES * 64), LDS_BYTES, stream, a);
    }
#endif
}
```
